# Optimizing an MI355X kernel written in HIP

```python
import math
import jax
import jax.numpy as jnp
from jax import lax
import numpy as np


D_MODEL = 2048
BATCH = 4
SEQ = 2048
DEPTH = 4

N_MIXERS = 2
N_MLA = (DEPTH + N_MIXERS - 1) // N_MIXERS
N_HGRN = DEPTH // N_MIXERS
RMS_EPS = 1e-6

MLA_HEADS = 16
Q_LORA = 512
KV_LORA = 512
QK_NOPE = 128
QK_ROPE = 64
QK_HEAD = QK_NOPE + QK_ROPE
V_HEAD = 128
MLA_A_DIM = Q_LORA + KV_LORA + QK_ROPE
ROPE_THETA = 10000.0
Q_BLOCK = 128

HGRN_HEADS = 16
HGRN_EXPAND = 128
HGRN_HEAD_V = D_MODEL // HGRN_HEADS
HGRN_FDIM = HGRN_HEADS * HGRN_EXPAND
HGRN_VDIM = HGRN_HEADS * HGRN_HEAD_V
HGRN_IN_DIM = 2 * HGRN_FDIM + 2 * HGRN_VDIM
CHUNK = 64

D_FF = 5632
CONV_W = 3

PLE_DIM = 256

kernel_name = 'hybrid_mla_hgrn2_convffn_ple'


def rms_norm(x, g):
    xf = x.astype(jnp.float32)
    y = xf * lax.rsqrt(jnp.mean(xf * xf, axis=-1, keepdims=True) + RMS_EPS)
    return (y * g.astype(jnp.float32)).astype(x.dtype)


def rope_tables(positions):
    inv_freq = ROPE_THETA ** (-jnp.arange(0, QK_ROPE, 2, dtype=jnp.float32) / QK_ROPE)
    ang = positions.astype(jnp.float32)[..., None] * inv_freq
    return jnp.cos(ang), jnp.sin(ang)


def apply_rope(x, cos, sin):
    c = cos[:, :, None, :].astype(x.dtype)
    s = sin[:, :, None, :].astype(x.dtype)
    x1, x2 = jnp.split(x, 2, axis=-1)
    return jnp.concatenate([x1 * c - x2 * s, x2 * c + x1 * s], axis=-1)


def causal_block_attention(q, k, v):
    B, S, H, dq = q.shape
    dv = v.shape[-1]
    nb = S // Q_BLOCK
    scale = 1.0 / math.sqrt(dq)
    kt = k.transpose(0, 2, 1, 3)
    vt = v.transpose(0, 2, 1, 3)
    qb = q.reshape(B, nb, Q_BLOCK, H, dq).transpose(1, 0, 3, 2, 4)
    key_pos = jnp.arange(S)

    def one_block(args):
        qblk, bi = args
        s = jnp.einsum('bhqd,bhkd->bhqk', qblk, kt).astype(jnp.float32) * scale
        q_pos = bi * Q_BLOCK + jnp.arange(Q_BLOCK)
        mask = key_pos[None, :] <= q_pos[:, None]
        s = jnp.where(mask, s, -jnp.inf)
        pr = jax.nn.softmax(s, axis=-1).astype(vt.dtype)
        return jnp.einsum('bhqk,bhkd->bhqd', pr, vt)

    o = lax.map(one_block, (qb, jnp.arange(nb)))
    return o.transpose(1, 0, 3, 2, 4).reshape(B, S, H * dv)


def mla_mixer(xn, cos, sin, w_a, q_norm, w_uq, kv_norm, w_ukv, qk_gain_q, qk_gain_k, w_o):
    B, S, _ = xn.shape
    c = xn @ w_a
    c_q = c[..., :Q_LORA]
    c_kv = c[..., Q_LORA:Q_LORA + KV_LORA]
    k_pe = c[..., Q_LORA + KV_LORA:]
    q = (rms_norm(c_q, q_norm) @ w_uq).reshape(B, S, MLA_HEADS, QK_HEAD)
    kv = (rms_norm(c_kv, kv_norm) @ w_ukv).reshape(B, S, MLA_HEADS, QK_NOPE + V_HEAD)
    k_nope = kv[..., :QK_NOPE]
    v = kv[..., QK_NOPE:]
    k = jnp.concatenate([k_nope, jnp.broadcast_to(k_pe[:, :, None, :], (B, S, MLA_HEADS, QK_ROPE))], axis=-1)
    q = rms_norm(q, qk_gain_q)
    k = rms_norm(k, qk_gain_k)
    q = jnp.concatenate([q[..., :QK_NOPE], apply_rope(q[..., QK_NOPE:], cos, sin)], axis=-1)
    k = jnp.concatenate([k[..., :QK_NOPE], apply_rope(k[..., QK_NOPE:], cos, sin)], axis=-1)
    o = causal_block_attention(q, k, v)
    return o @ w_o


def _hgrn_chunk_step(state, inp):
    q, k, v, log_f = inp
    b = jnp.cumsum(log_f, axis=2)
    o_inter = jnp.einsum('bhtd,bhde->bhte', q * jnp.exp(b), state)
    diff = b[:, :, :, None, :] - b[:, :, None, :, :]
    causal = jnp.tril(jnp.ones((CHUNK, CHUNK), dtype=bool))
    decay = jnp.exp(jnp.where(causal[:, :, None], diff, -jnp.inf))
    a = jnp.einsum('bhtd,bhsd,bhtsd->bhts', q, k, decay)
    o = o_inter + jnp.einsum('bhts,bhse->bhte', a, v)
    b_last = b[:, :, -1:, :]
    new_state = jnp.exp(b_last[:, :, 0, :])[..., None] * state + jnp.einsum('bhsd,bhse->bhde', k * jnp.exp(b_last - b), v)
    return new_state, o


def hgrn2_mixer(xn, lb, w_in, o_norm, w_o):
    B, T, _ = xn.shape
    nc = T // CHUNK
    f32 = jnp.float32
    z = xn @ w_in
    q_raw = z[..., :HGRN_FDIM]
    f_raw = z[..., HGRN_FDIM:2 * HGRN_FDIM]
    i_in = z[..., 2 * HGRN_FDIM:2 * HGRN_FDIM + HGRN_VDIM]
    g = z[..., 2 * HGRN_FDIM + HGRN_VDIM:]
    lbf = lb.astype(f32)
    ff = f_raw.astype(f32)
    log_f = jnp.log(lbf + (1.0 - lbf) * jax.nn.sigmoid(ff))
    k = (1.0 - lbf) * jax.nn.sigmoid(-ff)
    q = jax.nn.silu(q_raw.astype(f32))
    v = i_in.astype(f32)

    def to_chunks(t, d):
        return t.reshape(B, nc, CHUNK, HGRN_HEADS, d).transpose(1, 0, 3, 2, 4)

    s0 = jnp.zeros((B, HGRN_HEADS, HGRN_EXPAND, HGRN_HEAD_V), f32)
    _, o = lax.scan(_hgrn_chunk_step, s0, (to_chunks(q, HGRN_EXPAND), to_chunks(k, HGRN_EXPAND), to_chunks(v, HGRN_HEAD_V), to_chunks(log_f, HGRN_EXPAND)))
    o = o.transpose(1, 0, 3, 2, 4).reshape(B, T, HGRN_HEADS, HGRN_HEAD_V)
    o = rms_norm(o, o_norm.reshape(HGRN_HEADS, HGRN_HEAD_V)).astype(xn.dtype).reshape(B, T, HGRN_VDIM)
    o = o * jax.nn.silu(g)
    return o @ w_o


def conv_ffn(xn, w_in, conv_w, conv_b, w_down):
    T = xn.shape[1]
    gu = xn @ w_in
    gate = gu[..., :D_FF]
    up = gu[..., D_FF:]
    gp = jnp.pad(gate, ((0, 0), (CONV_W - 1, 0), (0, 0)))
    conv = conv_b + gp[:, 0:T] * conv_w[0]
    for tap in range(1, CONV_W):
        conv = conv + gp[:, tap:tap + T] * conv_w[tap]
    return (jax.nn.silu(conv) * up) @ w_down


def per_layer_embedding(h, p_i, norm_g, w_proj, w_gate):
    return (p_i @ w_proj) * jax.nn.sigmoid(rms_norm(h, norm_g) @ w_gate)


def _w(k, shape, fan_in):
    return jax.random.normal(k, shape, jnp.float32) * (fan_in ** -0.5)


def _gain(k, shape):
    return 1.0 + 0.02 * jax.random.normal(k, shape, jnp.float32)


def setup_inputs(seed: int = 0) -> dict:
    key = jax.random.key(seed)
    ks = jax.random.split(key, 26)
    x = jax.random.normal(ks[0], (BATCH, SEQ, D_MODEL), jnp.float32)
    p = jax.random.normal(ks[1], (DEPTH, BATCH, SEQ, PLE_DIM), jnp.float32)
    positions = (jnp.arange(SEQ, dtype=jnp.int32)[None, :] + jax.random.randint(ks[2], (BATCH, 1), 0, 4096, dtype=jnp.int32)).astype(jnp.int32)
    return {
        'x': x,
        'p': p,
        'positions': positions,
        'mix_norm': _gain(ks[3], (DEPTH, D_MODEL)),
        'ffn_norm': _gain(ks[4], (DEPTH, D_MODEL)),
        'ple_norm': _gain(ks[5], (DEPTH, D_MODEL)),
        'mla_w_a': _w(ks[6], (N_MLA, D_MODEL, MLA_A_DIM), D_MODEL),
        'mla_q_norm': _gain(ks[7], (N_MLA, Q_LORA)),
        'mla_w_uq': _w(ks[8], (N_MLA, Q_LORA, MLA_HEADS * QK_HEAD), Q_LORA),
        'mla_kv_norm': _gain(ks[9], (N_MLA, KV_LORA)),
        'mla_w_ukv': _w(ks[10], (N_MLA, KV_LORA, MLA_HEADS * (QK_NOPE + V_HEAD)), KV_LORA),
        'mla_qk_gain_q': _gain(ks[11], (N_MLA, QK_HEAD)),
        'mla_qk_gain_k': _gain(ks[12], (N_MLA, QK_HEAD)),
        'mla_w_o': _w(ks[13], (N_MLA, MLA_HEADS * V_HEAD, D_MODEL), MLA_HEADS * V_HEAD),
        'hgrn_lb_logits': 0.5 * jax.random.normal(ks[14], (DEPTH, HGRN_FDIM), jnp.float32),
        'hgrn_w_in': _w(ks[15], (N_HGRN, D_MODEL, HGRN_IN_DIM), D_MODEL),
        'hgrn_o_norm': _gain(ks[16], (N_HGRN, HGRN_VDIM)),
        'hgrn_w_o': _w(ks[17], (N_HGRN, HGRN_VDIM, D_MODEL), HGRN_VDIM),
        'ffn_w_in': _w(ks[18], (DEPTH, D_MODEL, 2 * D_FF), D_MODEL),
        'ffn_conv_w': _w(ks[19], (DEPTH, CONV_W, D_FF), CONV_W),
        'ffn_conv_b': 0.01 * jax.random.normal(ks[20], (DEPTH, D_FF), jnp.float32),
        'ffn_w_down': _w(ks[21], (DEPTH, D_FF, D_MODEL), D_FF),
        'ple_w_proj': _w(ks[22], (DEPTH, PLE_DIM, D_MODEL), PLE_DIM),
        'ple_w_gate': _w(ks[23], (DEPTH, D_MODEL, D_MODEL), D_MODEL),
    }


def reference(x, p, positions, mix_norm, ffn_norm, ple_norm, mla_w_a, mla_q_norm, mla_w_uq, mla_kv_norm, mla_w_ukv, mla_qk_gain_q, mla_qk_gain_k, mla_w_o, hgrn_lb_logits, hgrn_w_in, hgrn_o_norm, hgrn_w_o, ffn_w_in, ffn_conv_w, ffn_conv_b, ffn_w_down, ple_w_proj, ple_w_gate):
    cos, sin = rope_tables(positions)
    sm = jax.nn.softmax(hgrn_lb_logits.astype(jnp.float32), axis=0)
    lower_bounds = jnp.cumsum(sm, axis=0) - sm[0]
    h = x
    for i in range(DEPTH):
        j = i // N_MIXERS
        xn = rms_norm(h, mix_norm[i])
        if i % N_MIXERS == 0:
            h = h + mla_mixer(xn, cos, sin, mla_w_a[j], mla_q_norm[j], mla_w_uq[j], mla_kv_norm[j], mla_w_ukv[j], mla_qk_gain_q[j], mla_qk_gain_k[j], mla_w_o[j])
        else:
            h = h + hgrn2_mixer(xn, lower_bounds[i], hgrn_w_in[j], hgrn_o_norm[j], hgrn_w_o[j])
        h = h + conv_ffn(rms_norm(h, ffn_norm[i]), ffn_w_in[i], ffn_conv_w[i], ffn_conv_b[i], ffn_w_down[i])
        h = h + per_layer_embedding(h, p[i], ple_norm[i], ple_w_proj[i], ple_w_gate[i])
    return h
```

```cpp
#include <hip/hip_runtime.h>
#include <hip/hip_cooperative_groups.h>
#include <cstdio>
#include <cstdint>
namespace cg = cooperative_groups;

#ifndef PROBE_MASK
#define PROBE_MASK 0ull
#endif
#ifndef MK_ONE_LAUNCH
#define MK_ONE_LAUNCH 1
#endif

#define LAS __attribute__((address_space(3)))
typedef unsigned short bf16_t;
typedef short bf16x8 __attribute__((ext_vector_type(8)));
typedef float f32x4 __attribute__((ext_vector_type(4)));
typedef _Float16 f16x8 __attribute__((ext_vector_type(8)));
typedef float f32x16 __attribute__((ext_vector_type(16)));
typedef unsigned u32x4 __attribute__((ext_vector_type(4)));
typedef unsigned u32x2 __attribute__((ext_vector_type(2)));

__device__ __forceinline__ unsigned cvt_pk_bf16(float lo, float hi) { unsigned r; asm volatile("v_cvt_pk_bf16_f32 %0, %1, %2" : "=v"(r) : "v"(lo), "v"(hi)); return r; }
__device__ __forceinline__ float bf_lo(unsigned w) { return __uint_as_float(w << 16); }
__device__ __forceinline__ float bf_hi(unsigned w) { return __uint_as_float(w & 0xffff0000u); }
__device__ __forceinline__ float bf1(bf16_t b) { return __uint_as_float((unsigned)b << 16); }
__device__ __forceinline__ bf16_t f2bf(float f) { return (bf16_t)(cvt_pk_bf16(f, 0.f) & 0xffffu); }
__device__ __forceinline__ unsigned pk_f16(float lo, float hi) { return (unsigned)__builtin_bit_cast(unsigned short, (_Float16)lo) | ((unsigned)__builtin_bit_cast(unsigned short, (_Float16)hi) << 16); }
__device__ __forceinline__ float f16_lo(unsigned w) { return (float)__builtin_bit_cast(_Float16, (unsigned short)(w & 0xffffu)); }
__device__ __forceinline__ float f16_hi(unsigned w) { return (float)__builtin_bit_cast(_Float16, (unsigned short)(w >> 16)); }
__device__ __forceinline__ float sigmoidf_(float x) { return __builtin_amdgcn_rcpf(1.f + __builtin_amdgcn_exp2f(x * -1.4426950408889634f)); }
__device__ __forceinline__ float dot4(f32x4 a) { return (a[0] * a[0] + a[1] * a[1]) + (a[2] * a[2] + a[3] * a[3]); }
__device__ __forceinline__ void atomic_addf(float* p, float v) { (void)__hip_atomic_fetch_add(p, v, __ATOMIC_RELAXED, __HIP_MEMORY_SCOPE_AGENT); }

__device__ __forceinline__ void load8(const bf16_t* p, float (&v)[8]) { const u32x4 w = *(const u32x4*)p; v[0] = bf_lo(w.x); v[1] = bf_hi(w.x); v[2] = bf_lo(w.y); v[3] = bf_hi(w.y); v[4] = bf_lo(w.z); v[5] = bf_hi(w.z); v[6] = bf_lo(w.w); v[7] = bf_hi(w.w); }
__device__ __forceinline__ void unpack8(const u32x4 w, float (&v)[8]) { v[0] = bf_lo(w.x); v[1] = bf_hi(w.x); v[2] = bf_lo(w.y); v[3] = bf_hi(w.y); v[4] = bf_lo(w.z); v[5] = bf_hi(w.z); v[6] = bf_lo(w.w); v[7] = bf_hi(w.w); }
__device__ __forceinline__ void store8(bf16_t* p, const float (&v)[8]) { u32x4 w; w.x = cvt_pk_bf16(v[0], v[1]); w.y = cvt_pk_bf16(v[2], v[3]); w.z = cvt_pk_bf16(v[4], v[5]); w.w = cvt_pk_bf16(v[6], v[7]); *(u32x4*)p = w; }
__device__ __forceinline__ u32x4 pack_f16x8_(const f32x4 a, const f32x4 b) { u32x4 w; w.x = pk_f16(a[0], a[1]); w.y = pk_f16(a[2], a[3]); w.z = pk_f16(b[0], b[1]); w.w = pk_f16(b[2], b[3]); return w; }
constexpr int M = 8192, DM = 2048, SEQ = 2048, NB = 4, NH = 16;
constexpr int DFF = 5632, CA = 1280, NQ = 3072, NKV = 4096, NHG = 8192;
constexpr float EPS = 1e-6f;

namespace pg8 {
constexpr int BM = 256, BK = 64, HALF = 128, HTB = HALF * BK * 2, STAGE_BYTES = 8 * HTB, NXCD = 8, WGM = 8;
__host__ __device__ __forceinline__ int lds_byte(int r, int c) { const int st = (r >> 4) * 2 + (c >> 5), rr = r & 15, cc = c & 31, ob = rr * 64 + cc * 2; return st * 1024 + (ob ^ (((ob >> 9) & 1) << 5)); }
__host__ __device__ __forceinline__ void stage_rc(int b, int& R, int& C) { const int st = b / 1024, sb = b % 1024, swz = sb ^ (((sb >> 9) & 1) << 5); R = (st >> 1) * 16 + swz / 64; C = (st & 1) * 32 + (swz % 64) / 2; }
__host__ __device__ __forceinline__ int perm32(int rho) { const int n = rho >> 4, i = rho & 15; return 8 * (i >> 2) + 4 * n + (i & 3); }

struct Unit { int pm, pn; };
struct Gemm { const bf16_t* A; const bf16_t* Bt; int M, N, K, lda, ldb; };

struct StaticOrder {
    int nM, nN, nwg, G, c;
    __device__ void init(int M_, int N_, int G_, int c_) { nM = M_ / BM; nN = N_ / BM; nwg = nM * nN; G = G_; c = c_; }
    __device__ bool next(int i, Unit& u) const {
        const long L = (long)i * G + c; if (L >= nwg) return false;
        int wgid = (int)L; { const int q = nwg / NXCD, r = nwg % NXCD, xcd = wgid % NXCD, off = wgid / NXCD; wgid = (xcd < r ? xcd * (q + 1) : r * (q + 1) + (xcd - r) * q) + off; }
        const int nig = WGM * nN, gid = wgid / nig, fm = gid * WGM, gsz = (nM - fm) < WGM ? (nM - fm) : WGM;
        u.pm = fm + ((wgid % nig) % gsz); u.pn = (wgid % nig) / gsz; return true;
    }
};

typedef f32x4 Acc[2][2][4][2];
constexpr int LDS_RSTD = 131072 + 1024;
template <class Epi> __device__ __forceinline__ void rstd_issue(const Epi& E, int pm, int tid, f32x4 (&pf)[4]) {
    const f32x4* p = (const f32x4*)(E.ssq_in + (size_t)(pm * BM + (tid >> 1)) * 32); const int half = tid & 1;
    if (E.np4v() == 8) {
#pragma unroll
        for (int k = 0; k < 4; ++k) pf[k] = p[4 * half + k];
    } else { pf[0] = p[half]; pf[1] = (f32x4){0.f, 0.f, 0.f, 0.f}; pf[2] = pf[1]; pf[3] = pf[1]; }
}
template <class Epi> __device__ __forceinline__ void rstd_store(const Epi& E, const f32x4 (&pf)[4], LAS float* tab, int tid) {
    float s = 0.f;
#pragma unroll
    for (int k = 0; k < 4; ++k) s += (pf[k][0] + pf[k][1]) + (pf[k][2] + pf[k][3]);
    s += __shfl_xor(s, 1);
    if ((tid & 1) == 0) tab[tid >> 1] = rsqrtf(s * E.invn + 1e-6f);
}

template <class Epi>
__device__ __forceinline__ void gemm_phase(LAS unsigned char* lds, const Gemm g, const StaticOrder& S, const Epi& E, int tid_in) {
    const int tid = tid_in, wid = __builtin_amdgcn_readfirstlane(tid >> 6), lane = tid & 63, wr = wid >> 2, wc = wid & 3, fr = lane & 15, fq = lane >> 4;
    const int K = g.K, nt = K / BK;
    unsigned voffA[2], voffB[2];
#pragma unroll
    for (int i = 0; i < 2; ++i) { int R, C; stage_rc(tid * 16 + i * 8192, R, C); const int Rb = Epi::PERM ? ((R & ~31) + perm32(R & 31)) : R;
        voffA[i] = (unsigned)(R * g.lda + C) * 2u; voffB[i] = (unsigned)(Rb * g.ldb + C) * 2u; }
    const size_t kstep = (size_t)(BK * 2);
    const size_t hA = (size_t)HALF * g.lda * 2, hB = (size_t)HALF * g.ldb * 2;
    const size_t tA = 2 * hA, tB = 2 * hB;
    const unsigned ldsw = (unsigned)wid * 1024u;
    const int aoff = lds_byte(wr * 64 + fr, fq * 8), boff = lds_byte(wc * 32 + fr, fq * 8);
#define PG8_SA(b, h) (((b) * 2 + (h)) * HTB)
#define PG8_SB(b, h) ((4 + (b) * 2 + (h)) * HTB)
#define PG8_STAGE(bufoff, gbase, voff) do { _Pragma("unroll") for (int _i = 0; _i < 2; ++_i) \
        __builtin_amdgcn_global_load_lds((const unsigned*)((const char*)(gbase) + (voff)[_i]), (LAS unsigned*)(lds + (bufoff) + ldsw + _i * 8192), 16, 0, 0); } while (0)
#define PG8_LDA(dst, b, h) do { _Pragma("unroll") for (int m = 0; m < 4; ++m) _Pragma("unroll") for (int k = 0; k < 2; ++k) dst[m][k] = *(const LAS bf16x8*)(lds + PG8_SA(b, h) + aoff + m * 2048 + k * 1024); } while (0)
#define PG8_LDB(dst, b, h) do { _Pragma("unroll") for (int n = 0; n < 2; ++n) _Pragma("unroll") for (int k = 0; k < 2; ++k) dst[n][k] = *(const LAS bf16x8*)(lds + PG8_SB(b, h) + boff + n * 2048 + k * 1024); } while (0)
#define PG8_MMA(ai, bj, At, Bt) do { __builtin_amdgcn_s_setprio(1); _Pragma("unroll") for (int m = 0; m < 4; ++m) _Pragma("unroll") for (int n = 0; n < 2; ++n) _Pragma("unroll") for (int k = 0; k < 2; ++k) \
        { if constexpr (Epi::F16) acc[ai][bj][m][n] = __builtin_amdgcn_mfma_f32_16x16x32_f16(__builtin_bit_cast(f16x8, Bt[n][k]), __builtin_bit_cast(f16x8, At[m][k]), acc[ai][bj][m][n], 0, 0, 0); \
          else acc[ai][bj][m][n] = __builtin_amdgcn_mfma_f32_16x16x32_bf16(Bt[n][k], At[m][k], acc[ai][bj][m][n], 0, 0, 0); } __builtin_amdgcn_s_setprio(0); } while (0)
#define PG8_WAIT_V(n) asm volatile("s_waitcnt vmcnt(" #n ")" ::: "memory")
#define PG8_WAIT_L(n) asm volatile("s_waitcnt lgkmcnt(" #n ")" ::: "memory")
#define PG8_BAR __builtin_amdgcn_s_barrier()
#define PG8_SCHED __builtin_amdgcn_sched_barrier(0)
    Unit cur, nxt; int ui = 0;
    if (!S.next(0, cur)) return;
    Acc acc;
#pragma unroll
    for (int a = 0; a < 2; ++a)
#pragma unroll
        for (int b = 0; b < 2; ++b)
#pragma unroll
            for (int m = 0; m < 4; ++m)
#pragma unroll
                for (int n = 0; n < 2; ++n) acc[a][b][m][n] = (f32x4){0.f, 0.f, 0.f, 0.f};
    bf16x8 At[4][2], B0[2][2], B1[2][2];
    LAS float* rtab = (LAS float*)(lds + LDS_RSTD);
    f32x4 pf0[4]; if constexpr (Epi::RSTD) rstd_issue(E, cur.pm, tid, pf0);
    const char* cA = (const char*)g.A + (size_t)cur.pm * tA; const char* cB = (const char*)g.Bt + (size_t)cur.pn * tB;
    PG8_STAGE(PG8_SB(0, 0), cB, voffB); PG8_STAGE(PG8_SB(0, 1), cB + hB, voffB); PG8_STAGE(PG8_SA(0, 0), cA, voffA); PG8_STAGE(PG8_SA(0, 1), cA + hA, voffA);
    if (wr == 1) PG8_BAR;
    PG8_WAIT_V(2); PG8_BAR;
    if constexpr (Epi::RSTD) rstd_store(E, pf0, rtab, tid);
    PG8_STAGE(PG8_SB(1, 0), cB + kstep, voffB); PG8_STAGE(PG8_SA(1, 0), cA + kstep, voffA); PG8_STAGE(PG8_SB(1, 1), cB + hB + kstep, voffB);
    PG8_WAIT_V(6); PG8_BAR;
    for (;;) {
        const bool has_next = S.next(ui + 1, nxt);
        const char* nA = has_next ? (const char*)g.A + (size_t)nxt.pm * tA : cA; const char* nB = has_next ? (const char*)g.Bt + (size_t)nxt.pn * tB : cB;
        for (int t = 0; t < nt; t += 2) {
            const bool last = (t == nt - 2);
            const char* a1 = cA + (size_t)(t + 1) * kstep;
            const char* a2 = last ? nA : cA + (size_t)(t + 2) * kstep; const char* b2 = last ? nB : cB + (size_t)(t + 2) * kstep;
            const char* a3 = a2 + kstep; const char* b3 = b2 + kstep;
            PG8_LDB(B0, 0, 0); PG8_LDB(B1, 0, 1); PG8_SCHED; PG8_LDA(At, 0, 0); PG8_STAGE(PG8_SA(1, 1), a1 + hA, voffA);
            PG8_WAIT_V(8); PG8_WAIT_L(0); PG8_BAR; PG8_MMA(0, 0, At, B0); PG8_MMA(0, 1, At, B1); PG8_BAR; PG8_SCHED;
            PG8_LDA(At, 0, 1); PG8_STAGE(PG8_SB(0, 0), b2, voffB); PG8_STAGE(PG8_SB(0, 1), b2 + hB, voffB); PG8_STAGE(PG8_SA(0, 0), a2, voffA);
            PG8_WAIT_V(8); PG8_WAIT_L(0); PG8_BAR; PG8_MMA(1, 0, At, B0); PG8_MMA(1, 1, At, B1); PG8_BAR; PG8_SCHED;
            PG8_LDB(B0, 1, 0); PG8_LDB(B1, 1, 1); PG8_SCHED; PG8_LDA(At, 1, 0); PG8_STAGE(PG8_SA(0, 1), a2 + hA, voffA);
            PG8_WAIT_V(8); PG8_WAIT_L(0); PG8_BAR; PG8_MMA(0, 0, At, B0); PG8_MMA(0, 1, At, B1); PG8_BAR; PG8_SCHED;
            PG8_LDA(At, 1, 1); PG8_STAGE(PG8_SB(1, 0), b3, voffB); PG8_STAGE(PG8_SB(1, 1), b3 + hB, voffB); PG8_STAGE(PG8_SA(1, 0), a3, voffA);
            PG8_WAIT_V(8); PG8_WAIT_L(0); PG8_BAR; PG8_MMA(1, 0, At, B0); PG8_MMA(1, 1, At, B1); PG8_BAR; PG8_SCHED;
        }
        if (wr == 0) PG8_BAR;
        E(acc, cur, wr, wc, fr, fq, rtab + (ui & 1) * 256, has_next ? nxt.pm : -1, rtab + ((ui + 1) & 1) * 256, tid);
        if (!has_next) break;
#pragma unroll
        for (int a = 0; a < 2; ++a)
#pragma unroll
            for (int b = 0; b < 2; ++b)
#pragma unroll
                for (int m = 0; m < 4; ++m)
#pragma unroll
                    for (int n = 0; n < 2; ++n) acc[a][b][m][n] = (f32x4){0.f, 0.f, 0.f, 0.f};
        cur = nxt; cA = nA; cB = nB; ++ui;
        if (wr == 1) PG8_BAR;
    }
    PG8_WAIT_V(0);
    PG8_BAR;
#undef PG8_SA
#undef PG8_SB
#undef PG8_STAGE
#undef PG8_LDA
#undef PG8_LDB
#undef PG8_MMA
#undef PG8_WAIT_V
#undef PG8_WAIT_L
#undef PG8_BAR
#undef PG8_SCHED
}

__device__ __forceinline__ float row_rstd(const float* ssq, int r, float invn, int np4, int fq) {
    if (!ssq) return 1.f;
    const f32x4* p = (const f32x4*)(ssq + (size_t)r * 32); float s = 0.f;
    if (np4 == 8) { const f32x4 a = p[2 * fq], c = p[2 * fq + 1]; s = ((a[0] + a[1]) + (a[2] + a[3])) + ((c[0] + c[1]) + (c[2] + c[3])); }
    else if (fq < 2) { const f32x4 a = p[fq]; s = (a[0] + a[1]) + (a[2] + a[3]); }
    s += __shfl_xor(s, 16); s += __shfl_xor(s, 32);
    return rsqrtf(s * invn + EPS);
}
__device__ __forceinline__ void row_rstd4(const float* ssq, int rowh, float invn, int np4, int fq, float (&rs)[4]) {
    if (!ssq) {
#pragma unroll
        for (int m = 0; m < 4; ++m) rs[m] = 1.f;
        return; }
    float sp[4];
#pragma unroll
    for (int m = 0; m < 4; ++m) { const f32x4* p = (const f32x4*)(ssq + (size_t)(rowh + m * 16) * 32); float s = 0.f;
        if (np4 == 8) { const f32x4 a = p[2 * fq], c = p[2 * fq + 1]; s = ((a[0] + a[1]) + (a[2] + a[3])) + ((c[0] + c[1]) + (c[2] + c[3])); }
        else if (fq < 2) { const f32x4 a = p[fq]; s = (a[0] + a[1]) + (a[2] + a[3]); }
        sp[m] = s; }
#pragma unroll
    for (int m = 0; m < 4; ++m) { float s = sp[m]; s += __shfl_xor(s, 16); s += __shfl_xor(s, 32); rs[m] = rsqrtf(s * invn + EPS); }
}
__device__ __forceinline__ u32x4 pack8(f32x4 a, f32x4 b) { u32x4 w; w.x = cvt_pk_bf16(a[0], a[1]); w.y = cvt_pk_bf16(a[2], a[3]); w.z = cvt_pk_bf16(b[0], b[1]); w.w = cvt_pk_bf16(b[2], b[3]); return w; }

template <bool F16_> struct EpiBf16S {
    static constexpr bool PERM = true, RSTD = true, F16 = F16_;
    __device__ __forceinline__ int np4v() const { return np4; }
    bf16_t* O; int ldc; const float* ssq_in; float invn; int np4; float* ssq0; float* ssq1;
    __device__ __forceinline__ void operator()(const Acc& acc, const Unit& u, int wr, int wc, int fr, int fq, const LAS float* tab, int nxt_pm, LAS float* ntab, int tid) const {
        const int row0 = u.pm * BM + wr * 64 + fr, col0 = u.pn * BM + wc * 32 + 8 * fq;
        float* sq = ssq0 ? (u.pn < 2 ? ssq0 : (u.pn < 4 ? ssq1 : nullptr)) : nullptr;
        f32x4 pf[4]; if (nxt_pm >= 0) rstd_issue(*this, nxt_pm, tid, pf);
#pragma unroll
        for (int ai = 0; ai < 2; ++ai) {
#pragma unroll
            for (int m = 0; m < 4; ++m) { const int r = row0 + ai * HALF + m * 16; const float rs = tab[ai * HALF + wr * 64 + m * 16 + fr]; float part = 0.f;
#pragma unroll
                for (int bj = 0; bj < 2; ++bj) { const f32x4 v0 = acc[ai][bj][m][0] * rs, v1 = acc[ai][bj][m][1] * rs; part += dot4(v0) + dot4(v1);
                    *(u32x4*)(O + (size_t)r * ldc + col0 + bj * HALF) = pack8(v0, v1); }
                if (sq) { part += __shfl_xor(part, 16); part += __shfl_xor(part, 32); if (fq == 0) sq[(size_t)r * 32 + (u.pn & 1) * 4 + wc] = part; } } }
        if (nxt_pm >= 0) rstd_store(*this, pf, ntab, tid);
    }
};
__device__ __forceinline__ float dpp_ror1(float x) { return __builtin_bit_cast(float, __builtin_amdgcn_update_dpp(0, __builtin_bit_cast(int, x), 0x121, 0xf, 0xf, false)); }
__device__ __forceinline__ float dpp_ror2(float x) { return __builtin_bit_cast(float, __builtin_amdgcn_update_dpp(0, __builtin_bit_cast(int, x), 0x122, 0xf, 0xf, false)); }
struct EpiFfnIn {
    static constexpr bool PERM = true, RSTD = true, F16 = true;
    __device__ __forceinline__ int np4v() const { return 8; }
    bf16_t* Gt; bf16_t* Up; bf16_t* Act; const float* ssq_in; float invn; const float* cw; const float* cb;
    __device__ __forceinline__ void operator()(const Acc& acc, const Unit& u, int wr, int wc, int fr, int fq, const LAS float* tab, int nxt_pm, LAS float* ntab, int tid) const {
        const int row0 = u.pm * BM + wr * 64 + fr, col0 = u.pn * HALF + wc * 32 + 8 * fq;
        float w0[8], w1[8], w2[8], bb[8];
#pragma unroll
        for (int h = 0; h < 2; ++h) { const f32x4 a = *(const f32x4*)(cw + col0 + 4 * h), b = *(const f32x4*)(cw + DFF + col0 + 4 * h), c = *(const f32x4*)(cw + 2 * DFF + col0 + 4 * h), d = *(const f32x4*)(cb + col0 + 4 * h);
#pragma unroll
            for (int j = 0; j < 4; ++j) { w0[4 * h + j] = a[j]; w1[4 * h + j] = b[j]; w2[4 * h + j] = c[j]; bb[4 * h + j] = d[j]; } }
        f32x4 pf[4]; if (nxt_pm >= 0) rstd_issue(*this, nxt_pm, tid, pf);
#pragma unroll
        for (int ai = 0; ai < 2; ++ai) {
            float p1[8] = {0.f, 0.f, 0.f, 0.f, 0.f, 0.f, 0.f, 0.f}, p2[8] = {0.f, 0.f, 0.f, 0.f, 0.f, 0.f, 0.f, 0.f};
#pragma unroll
            for (int m = 0; m < 4; ++m) { const int r = row0 + ai * HALF + m * 16; const float rs = tab[ai * HALF + wr * 64 + m * 16 + fr];
                float g[8], up[8], r1[8], r2[8], o[8];
#pragma unroll
                for (int j = 0; j < 4; ++j) { g[j] = acc[ai][0][m][0][j] * rs; g[4 + j] = acc[ai][0][m][1][j] * rs; up[j] = acc[ai][1][m][0][j] * rs; up[4 + j] = acc[ai][1][m][1][j] * rs; }
#pragma unroll
                for (int j = 0; j < 8; ++j) { r1[j] = dpp_ror1(g[j]); r2[j] = dpp_ror2(g[j]); }
                const size_t off = (size_t)r * DFF + col0;
                if (m == 0 && fr < 2) { store8(Gt + off, g); store8(Up + off, up); }
                else {
#pragma unroll
                    for (int j = 0; j < 8; ++j) { const float a1 = (fr >= 1) ? r1[j] : p1[j], a2 = (fr >= 2) ? r2[j] : p2[j]; const float cv = bb[j] + w0[j] * a2 + w1[j] * a1 + w2[j] * g[j]; o[j] = cv * sigmoidf_(cv) * up[j]; }
                    store8(Act + off, o);
                    if (m == 3 && fr >= 14) store8(Gt + off, g);
                }
#pragma unroll
                for (int j = 0; j < 8; ++j) { p1[j] = r1[j]; p2[j] = r2[j]; }
            }
        }
        if (nxt_pm >= 0) rstd_store(*this, pf, ntab, tid);
    }
};
struct EpiHgrnIn {
    static constexpr bool PERM = true, RSTD = true, F16 = true;
    __device__ __forceinline__ int np4v() const { return 8; }
    bf16_t* QS; bf16_t* LOGF; bf16_t* KK; bf16_t* V; bf16_t* GS; const float* lb; const float* ssq_in; float invn;
    __device__ __forceinline__ void operator()(const Acc& acc, const Unit& u, int wr, int wc, int fr, int fq, const LAS float* tab, int nxt_pm, LAS float* ntab, int tid) const {
        const int part = u.pn >> 3;
        const int row0 = u.pm * BM + wr * 64 + fr, col0 = (u.pn & 7) * BM + wc * 32 + 8 * fq;
        f32x4 l0[2], l1[2];
        if (part == 1) {
#pragma unroll
            for (int bj = 0; bj < 2; ++bj) { l0[bj] = *(const f32x4*)(lb + col0 + bj * HALF); l1[bj] = *(const f32x4*)(lb + col0 + bj * HALF + 4); }
        }
        f32x4 pf[4]; if (nxt_pm >= 0) rstd_issue(*this, nxt_pm, tid, pf);
#pragma unroll
        for (int ai = 0; ai < 2; ++ai) {
#pragma unroll
            for (int m = 0; m < 4; ++m) { const int r = row0 + ai * HALF + m * 16; const float rs = tab[ai * HALF + wr * 64 + m * 16 + fr];
#pragma unroll
                for (int bj = 0; bj < 2; ++bj) { f32x4 v0 = acc[ai][bj][m][0] * rs, v1 = acc[ai][bj][m][1] * rs; const size_t o = (size_t)r * DM + col0 + bj * HALF;
                    if (part == 0 || part == 3) {
#pragma unroll
                        for (int j = 0; j < 4; ++j) { v0[j] = v0[j] * sigmoidf_(v0[j]); v1[j] = v1[j] * sigmoidf_(v1[j]); }
                        *(u32x4*)((part == 0 ? QS : GS) + o) = pack8(v0, v1);
                    } else if (part == 2) {
                        *(u32x4*)(V + o) = pack8(v0, v1);
                    } else {
                        f32x4 lf0, lf1;
#pragma unroll
                        for (int j = 0; j < 4; ++j) { const float s0 = sigmoidf_(v0[j]), s1 = sigmoidf_(v1[j]); const float a0 = l0[bj][j], a1 = l1[bj][j];
                            lf0[j] = __logf(a0 + (1.f - a0) * s0); lf1[j] = __logf(a1 + (1.f - a1) * s1); }
                        *(u32x4*)(LOGF + o) = pack_f16x8_(lf0, lf1);
                    } } } }
        if (nxt_pm >= 0) rstd_store(*this, pf, ntab, tid);
    }
};
__device__ __forceinline__ void unpack_f16x8(const u32x4 w, f32x4& a, f32x4& b) { a = (f32x4){f16_lo(w.x), f16_hi(w.x), f16_lo(w.y), f16_hi(w.y)}; b = (f32x4){f16_lo(w.z), f16_hi(w.z), f16_lo(w.w), f16_hi(w.w)}; }
__device__ __forceinline__ u32x4 pack_f16x8(const f32x4 a, const f32x4 b) { u32x4 w; w.x = pk_f16(a[0], a[1]); w.y = pk_f16(a[2], a[3]); w.z = pk_f16(b[0], b[1]); w.w = pk_f16(b[2], b[3]); return w; }
struct EpiRes {
    static constexpr bool PERM = true, RSTD = false, F16 = false;
    const float* base32; const bf16_t* base16; bf16_t* hb; bf16_t* hf; float* ssq_out; float* out32;
    __device__ __forceinline__ void operator()(const Acc& acc, const Unit& u, int wr, int wc, int fr, int fq, const LAS float* tab, int nxt_pm, LAS float* ntab, int tid) const {
        const int row0 = u.pm * BM + wr * 64 + fr, col0 = u.pn * BM + wc * 32 + 8 * fq;
        u32x4 bw[2][4][2];
        if (!base32) {
#pragma unroll
            for (int ai = 0; ai < 2; ++ai)
#pragma unroll
                for (int m = 0; m < 4; ++m)
#pragma unroll
                    for (int bj = 0; bj < 2; ++bj) bw[ai][m][bj] = *(const u32x4*)(base16 + (size_t)(row0 + ai * HALF + m * 16) * DM + col0 + bj * HALF);
        }
#pragma unroll
        for (int am = 0; am < 4; ++am) { const int ai = am >> 1, mb = (am & 1) * 2;
            f32x4 b0[4][2], b1[4][2];
            if (base32) {
#pragma unroll
                for (int m = mb; m < mb + 2; ++m)
#pragma unroll
                    for (int bj = 0; bj < 2; ++bj) { const float* p = base32 + (size_t)(row0 + ai * HALF + m * 16) * DM + col0 + bj * HALF; b0[m][bj] = *(const f32x4*)p; b1[m][bj] = *(const f32x4*)(p + 4); }
            } else {
#pragma unroll
                for (int m = mb; m < mb + 2; ++m)
#pragma unroll
                    for (int bj = 0; bj < 2; ++bj) unpack_f16x8(bw[ai][m][bj], b0[m][bj], b1[m][bj]);
            }
#pragma unroll
            for (int m = mb; m < mb + 2; ++m) { const int r = row0 + ai * HALF + m * 16; float part = 0.f;
#pragma unroll
                for (int bj = 0; bj < 2; ++bj) { const size_t o = (size_t)r * DM + col0 + bj * HALF;
                    const f32x4 v0 = b0[m][bj] + acc[ai][bj][m][0], v1 = b1[m][bj] + acc[ai][bj][m][1]; part += dot4(v0) + dot4(v1);
                    *(u32x4*)(hf + o) = pack_f16x8(v0, v1);
                    if (out32) { *(f32x4*)(out32 + o) = v0; *(f32x4*)(out32 + o + 4) = v1; } }
                part += __shfl_xor(part, 16); part += __shfl_xor(part, 32); if (fq == 0) ssq_out[(size_t)r * 32 + u.pn * 4 + wc] = part; }
        }
    }
};
struct EpiProj {
    static constexpr bool PERM = true, RSTD = false, F16 = false;
    bf16_t* P;
    __device__ __forceinline__ void operator()(const Acc& acc, const Unit& u, int wr, int wc, int fr, int fq, const LAS float* tab, int nxt_pm, LAS float* ntab, int tid) const {
        const int row0 = u.pm * BM + wr * 64 + fr, col0 = u.pn * BM + wc * 32 + 8 * fq;
#pragma unroll
        for (int ai = 0; ai < 2; ++ai)
#pragma unroll
            for (int m = 0; m < 4; ++m) { const int r = row0 + ai * HALF + m * 16;
#pragma unroll
                for (int bj = 0; bj < 2; ++bj) *(u32x4*)(P + (size_t)r * DM + col0 + bj * HALF) = pack8(acc[ai][bj][m][0], acc[ai][bj][m][1]); }
    }
};
struct EpiPle {
    static constexpr bool PERM = true, RSTD = true, F16 = true;
    __device__ __forceinline__ int np4v() const { return 8; }
    const bf16_t* base16; bf16_t* hb; bf16_t* hf; float* ssq_out; const bf16_t* P; const float* ssq_in; float invn; float* out32;
    __device__ __forceinline__ void operator()(const Acc& acc, const Unit& u, int wr, int wc, int fr, int fq, const LAS float* tab, int nxt_pm, LAS float* ntab, int tid) const {
        const int row0 = u.pm * BM + wr * 64 + fr, col0 = u.pn * BM + wc * 32 + 8 * fq;
#pragma unroll
        for (int am = 0; am < 4; ++am) { const int ai = am >> 1, mb = (am & 1) * 2;
            u32x4 bw[4][2], pv[4][2];
#pragma unroll
            for (int m = mb; m < mb + 2; ++m)
#pragma unroll
                for (int bj = 0; bj < 2; ++bj) { const size_t o = (size_t)(row0 + ai * HALF + m * 16) * DM + col0 + bj * HALF; bw[m][bj] = *(const u32x4*)(base16 + o); pv[m][bj] = *(const u32x4*)(P + o); }
#pragma unroll
            for (int m = mb; m < mb + 2; ++m) { const int r = row0 + ai * HALF + m * 16; const float rs = tab[ai * HALF + wr * 64 + m * 16 + fr]; float part = 0.f;
#pragma unroll
                for (int bj = 0; bj < 2; ++bj) { const size_t o = (size_t)r * DM + col0 + bj * HALF;
                    f32x4 h0, h1; unpack_f16x8(bw[m][bj], h0, h1); const u32x4 pw = pv[m][bj]; const f32x4 a0 = acc[ai][bj][m][0] * rs, a1 = acc[ai][bj][m][1] * rs; f32x4 v0, v1;
                    v0[0] = h0[0] + bf_lo(pw.x) * sigmoidf_(a0[0]); v0[1] = h0[1] + bf_hi(pw.x) * sigmoidf_(a0[1]); v0[2] = h0[2] + bf_lo(pw.y) * sigmoidf_(a0[2]); v0[3] = h0[3] + bf_hi(pw.y) * sigmoidf_(a0[3]);
                    v1[0] = h1[0] + bf_lo(pw.z) * sigmoidf_(a1[0]); v1[1] = h1[1] + bf_hi(pw.z) * sigmoidf_(a1[1]); v1[2] = h1[2] + bf_lo(pw.w) * sigmoidf_(a1[2]); v1[3] = h1[3] + bf_hi(pw.w) * sigmoidf_(a1[3]);
                    part += dot4(v0) + dot4(v1);
                    if (out32) { *(f32x4*)(out32 + o) = v0; *(f32x4*)(out32 + o + 4) = v1; }
                    else *(u32x4*)(hf + o) = pack_f16x8(v0, v1); }
                part += __shfl_xor(part, 16); part += __shfl_xor(part, 32); if (fq == 0) ssq_out[(size_t)r * 32 + u.pn * 4 + wc] = part; }
        }
    }
};
}

constexpr size_t MiB = 1u << 20;
constexpr size_t OFF_SSQ = 956 * MiB;
constexpr size_t OFF_LB = 1 * MiB;
constexpr size_t OFF_ROPE = 2 * MiB;
constexpr size_t OFF_G = 4 * MiB;
constexpr size_t OFF_W = 8 * MiB;
constexpr size_t OFF_WMLA = OFF_W + 300 * MiB;
constexpr size_t OFF_WHG = OFF_W + 340 * MiB;
constexpr size_t OFF_HB0 = 428 * MiB, OFF_HB1 = 460 * MiB;
constexpr size_t OFF_PB = 492 * MiB;
constexpr size_t OFF_PROJ = 508 * MiB;
constexpr size_t OFF_SCR = 540 * MiB;
constexpr size_t OFF_HF0 = 976 * MiB, OFF_HF1 = 1008 * MiB;
constexpr size_t WS_NEED = 1040 * MiB;
constexpr size_t S_C = OFF_SCR, S_QRAW = OFF_SCR + 20 * MiB, S_KVRAW = OFF_SCR + 68 * MiB, S_Q = OFF_SCR + 132 * MiB, S_K = OFF_SCR + 180 * MiB, S_VT = OFF_SCR + 228 * MiB, S_O = OFF_SCR + 260 * MiB;
constexpr size_t S_QS = OFF_SCR, S_LOGF = OFF_SCR + 32 * MiB, S_KK = OFF_SCR + 96 * MiB, S_V = OFF_SCR + 128 * MiB, S_GS = OFF_SCR + 160 * MiB, S_UT = OFF_SCR + 192 * MiB, S_SP = OFF_SCR + 320 * MiB, S_OG = OFF_SCR + 384 * MiB;
constexpr size_t S_GATE = OFF_SCR, S_UP = OFF_SCR + 88 * MiB, S_ACT = OFF_SCR + 176 * MiB;

constexpr int LDS_BYTES = 147456;

struct TrDesc { const float* W; const float* gain; bf16_t* WT; int K, N, ldk, mode; };
struct Params {
    const float* in[24];
    float* out; unsigned char* ws;
    TrDesc tr[28];
    int ph_lo, ph_hi;
};
typedef const __attribute__((address_space(4))) Params* PP;

__device__ __forceinline__ float wave_sum(float v) {
#pragma unroll
    for (int o = 1; o < 64; o <<= 1) v += __shfl_xor(v, o);
    return v;
}

__device__ __forceinline__ void tr_item(const float* W, int N, const float* gain, bf16_t* WT, int ldk, int k0, int n0, int drow0, LAS unsigned* scr, int lane, bool f16) {
    const int kr = lane >> 4, n4 = (lane & 15) * 4;
    f32x4 v[16];
#pragma unroll
    for (int i = 0; i < 8; ++i) { const float* src = W + (size_t)(k0 + 8 * i + 2 * kr) * N + n0 + n4; v[2 * i] = *(const f32x4*)src; v[2 * i + 1] = *(const f32x4*)(src + N); }
#pragma unroll
    for (int i = 0; i < 8; ++i) { const int k = 8 * i + 2 * kr; float g0 = 1.f, g1 = 1.f; if (gain) { g0 = gain[k0 + k]; g1 = gain[k0 + k + 1]; }
#pragma unroll
        for (int j = 0; j < 4; ++j) scr[(n4 + j) * 33 + (k >> 1)] = f16 ? pk_f16(v[2 * i][j] * g0, v[2 * i + 1][j] * g1) : cvt_pk_bf16(v[2 * i][j] * g0, v[2 * i + 1][j] * g1); }
    asm volatile("s_waitcnt lgkmcnt(0)" ::: "memory");
#pragma unroll
    for (int qd = 0; qd < 8; ++qd) { const int c = lane + 64 * qd, n = c >> 3, kc = (c & 7) * 4; const LAS unsigned* sp = scr + n * 33 + kc;
        u32x4 o; o.x = sp[0]; o.y = sp[1]; o.z = sp[2]; o.w = sp[3];
        *(u32x4*)(WT + (size_t)(drow0 + n) * ldk + k0 + 2 * kc) = o; }
    asm volatile("s_waitcnt lgkmcnt(0)" ::: "memory");
}

__device__ __forceinline__ void convert_descs(PP pp, LAS unsigned char* lds, int slot, int gw, int NGW, int wave, int lane) {
    LAS unsigned* scr = (LAS unsigned*)(lds + wave * 16384);
    for (int d = 0; d < 28; ++d) {
        const int mode = pp->tr[d].mode; if ((mode >> 4) != slot) continue;
        const float* W = pp->tr[d].W; const float* gain = pp->tr[d].gain; bf16_t* WT = pp->tr[d].WT; const int K = pp->tr[d].K, N = pp->tr[d].N, ldk = pp->tr[d].ldk;
        const int nblk = N / 64, nitems = (K / 64) * nblk;
        for (int it = gw; it < nitems; it += NGW) {
            const int kb = it / nblk, nb = it % nblk, n0 = nb * 64; int drow0 = n0;
            if (mode & 1) { const int up = n0 >= DFF ? 1 : 0, cc = n0 - up * DFF; drow0 = (cc >> 7) * 256 + up * 128 + (cc & 127); }
            tr_item(W, N, gain, WT, ldk, kb * 64, n0, drow0, scr, lane, (mode & 2) != 0);
        }
    }
}
__device__ __forceinline__ void prologue(PP pp, LAS unsigned char* lds, int G, int bid, int tid_in) {
    const int tid = tid_in, lane = tid & 63, wave = __builtin_amdgcn_readfirstlane(tid >> 6);
    const int gw = bid * 8 + wave, NGW = G * 8;
    const int gt = bid * 512 + tid, NGT = G * 512;
    unsigned char* ws = pp->ws;
    convert_descs(pp, lds, 0, gw, NGW, wave, lane);
    for (int j = 0; j < 2; ++j) { u32x4* z = (u32x4*)(ws + OFF_WMLA + j * 20 * MiB + (size_t)1088 * DM * 2); const int n16 = 192 * DM * 2 / 16;
        for (int i = gt; i < n16; i += NGT) z[i] = (u32x4){0u, 0u, 0u, 0u}; }
    { const float* x = pp->in[0]; bf16_t* hb = (bf16_t*)(ws + OFF_HF0); float* ssq = (float*)(ws + OFF_SSQ);
      for (int r = gw; r < M; r += NGW) { const f32x4* xr = (const f32x4*)(x + (size_t)r * DM) + lane; u32x2* o = (u32x2*)(hb + (size_t)r * DM) + lane; float s = 0.f;
#pragma unroll
          for (int j = 0; j < 8; ++j) { const f32x4 v = xr[64 * j]; s += dot4(v); u32x2 w; w.x = pk_f16(v[0], v[1]); w.y = pk_f16(v[2], v[3]); o[64 * j] = w; }
          s = wave_sum(s); if (lane < 32) ssq[(size_t)r * 32 + lane] = lane == 0 ? s : 0.f; } }
    { const f32x4* src = (const f32x4*)pp->in[1]; u32x2* dst = (u32x2*)(ws + OFF_PB); const int n4 = 4 * M * 256 / 4;
      for (int i0 = gt; i0 < n4; i0 += 8 * NGT) { f32x4 v[8];
#pragma unroll
          for (int k = 0; k < 8; ++k) { const int i = i0 + k * NGT; v[k] = src[i < n4 ? i : gt]; }
#pragma unroll
          for (int k = 0; k < 8; ++k) { const int i = i0 + k * NGT; if (i < n4) { u32x2 w; w.x = cvt_pk_bf16(v[k][0], v[k][1]); w.y = cvt_pk_bf16(v[k][2], v[k][3]); dst[i] = w; } } } }
    { const float* lg = pp->in[14]; float* lb = (float*)(ws + OFF_LB);
      for (int c = gt; c < DM; c += NGT) { const float a0 = lg[c], a1 = lg[DM + c], a2 = lg[2 * DM + c], a3 = lg[3 * DM + c]; const float mx = fmaxf(fmaxf(a0, a1), fmaxf(a2, a3));
          const float e0 = expf(a0 - mx), e1 = expf(a1 - mx), e2 = expf(a2 - mx), e3 = expf(a3 - mx); const float inv = 1.f / (e0 + e1 + e2 + e3);
          lb[c] = 0.f; lb[DM + c] = e1 * inv; lb[2 * DM + c] = (e1 + e2) * inv; lb[3 * DM + c] = (e1 + e2 + e3) * inv; } }
    { const int* pos = (const int*)pp->in[2]; float* ct = (float*)(ws + OFF_ROPE); float* st = ct + M * 32;
      for (int i = gt; i < M * 32; i += NGT) { const int r = i >> 5, f = i & 31; const float inv = exp2f(-(float)f * (13.287712379549449f / 32.f)); const float ang = (float)pos[r] * inv;
          const double a = (double)ang; const double k = rint(a * 0.15915494309189535); const float rr = (float)(a - k * 6.283185307179586);
          ct[i] = __cosf(rr); st[i] = __sinf(rr); } }
}


__device__ __forceinline__ void norm_rope_192(float (&x)[3][8], const float* gain, const float* ct, const float* st, int sub, float outscale) {
    float ss = 0.f;
#pragma unroll
    for (int g = 0; g < 3; ++g)
#pragma unroll
        for (int j = 0; j < 8; ++j) ss += x[g][j] * x[g][j];
    ss += __shfl_xor(ss, 1); ss += __shfl_xor(ss, 2); ss += __shfl_xor(ss, 4);
    const float rs = rsqrtf(ss * (1.f / 192.f) + EPS);
#pragma unroll
    for (int g = 0; g < 3; ++g) { const f32x4 g0 = *(const f32x4*)(gain + 64 * g + 8 * sub), g1 = *(const f32x4*)(gain + 64 * g + 8 * sub + 4);
#pragma unroll
        for (int j = 0; j < 4; ++j) { x[g][j] = x[g][j] * rs * g0[j]; x[g][4 + j] = x[g][4 + j] * rs * g1[j]; } }
    const int i0 = 8 * (sub & 3);
    const f32x4 c0 = *(const f32x4*)(ct + i0), c1 = *(const f32x4*)(ct + i0 + 4), s0 = *(const f32x4*)(st + i0), s1 = *(const f32x4*)(st + i0 + 4);
#pragma unroll
    for (int j = 0; j < 8; ++j) { const float mine = x[2][j], other = __shfl_xor(mine, 4); const float c = j < 4 ? c0[j & 3] : c1[j & 3], s = j < 4 ? s0[j & 3] : s1[j & 3];
        x[2][j] = (sub < 4) ? (mine * c - other * s) : (mine * c + other * s); }
#pragma unroll
    for (int g = 0; g < 3; ++g)
#pragma unroll
        for (int j = 0; j < 8; ++j) x[g][j] *= outscale;
}

__device__ __forceinline__ void mla_prep(PP pp, LAS unsigned char* lds, int G, int bid, int tid_in, int j) {
    unsigned char* ws = pp->ws;
    const bf16_t* qraw = (const bf16_t*)(ws + S_QRAW); const bf16_t* kvraw = (const bf16_t*)(ws + S_KVRAW); const bf16_t* cc = (const bf16_t*)(ws + S_C);
    bf16_t* Q = (bf16_t*)(ws + S_Q); bf16_t* Kd = (bf16_t*)(ws + S_K); bf16_t* Vt = (bf16_t*)(ws + S_VT);
    const float* gq = pp->in[11] + j * 192; const float* gk = pp->in[12] + j * 192;
    const float* ct = (const float*)(ws + OFF_ROPE); const float* st = ct + M * 32;
    const int tid = tid_in, t = tid >> 3, sub = tid & 7;
    LAS bf16_t* Vl = (LAS bf16_t*)lds;
    const float qscale = 0.07216878364870322f * 1.4426950408889634f;
    for (int it = bid; it < 128 * 16; it += G) {
        const int tb = it >> 4, h = it & 15; const int row = tb * 64 + t, b = row >> 11, s = row & 2047;
        u32x4 rq[3], rk[3], rv[2];
#pragma unroll
        for (int g = 0; g < 3; ++g) rq[g] = *(const u32x4*)(qraw + (size_t)row * NQ + h * 192 + 64 * g + 8 * sub);
#pragma unroll
        for (int g = 0; g < 2; ++g) rk[g] = *(const u32x4*)(kvraw + (size_t)row * NKV + h * 256 + 64 * g + 8 * sub);
        rk[2] = *(const u32x4*)(cc + (size_t)row * CA + 1024 + 8 * sub);
        { const bf16_t* vp = kvraw + (size_t)row * NKV + h * 256 + 128 + 16 * sub; rv[0] = *(const u32x4*)vp; rv[1] = *(const u32x4*)(vp + 8); }
        float x[3][8];
#pragma unroll
        for (int g = 0; g < 3; ++g) unpack8(rq[g], x[g]);
        norm_rope_192(x, gq, ct + row * 32, st + row * 32, sub, qscale);
        bf16_t* qo = Q + ((size_t)(b * NH + h) * SEQ + s) * 192 + 8 * sub;
#pragma unroll
        for (int g = 0; g < 3; ++g) store8(qo + 64 * g, x[g]);
#pragma unroll
        for (int g = 0; g < 3; ++g) unpack8(rk[g], x[g]);
        norm_rope_192(x, gk, ct + row * 32, st + row * 32, sub, 1.f);
        bf16_t* ko = Kd + ((size_t)(b * NH + h) * SEQ + s) * 192 + 8 * sub;
#pragma unroll
        for (int g = 0; g < 3; ++g) store8(ko + 64 * g, x[g]);
        { const u32x4 w0 = rv[0], w1 = rv[1];
          LAS u32x2* d = (LAS u32x2*)(Vl + t * 132 + 16 * sub); d[0] = (u32x2){w0.x, w0.y}; d[1] = (u32x2){w0.z, w0.w}; d[2] = (u32x2){w1.x, w1.y}; d[3] = (u32x2){w1.z, w1.w}; }
        __syncthreads();
        { const int d = tid >> 2, qd = tid & 3; unsigned w[8];
#pragma unroll
          for (int pp = 0; pp < 8; ++pp) { const int p0 = 2 * pp, p1 = 2 * pp + 1; const int o0 = (p0 & 3) | ((p0 & 4) << 1) | ((p0 & 8) >> 1), o1 = (p1 & 3) | ((p1 & 4) << 1) | ((p1 & 8) >> 1);
              w[pp] = (unsigned)Vl[(16 * qd + o0) * 132 + d] | ((unsigned)Vl[(16 * qd + o1) * 132 + d] << 16); }
          bf16_t* vo = Vt + ((size_t)(b * NH + h) * 128 + d) * SEQ + (tb * 64 & 2047) + 16 * qd;
          *(u32x4*)vo = (u32x4){w[0], w[1], w[2], w[3]}; *(u32x4*)(vo + 8) = (u32x4){w[4], w[5], w[6], w[7]}; }
        __syncthreads();
    }
}

constexpr int AT_KROW = 400, AT_VROW = 144, AT_KBYTES = 64 * AT_KROW, AT_BUF = 45056;
__device__ __forceinline__ void attn_unit(LAS unsigned char* lds, const bf16_t* Q, const bf16_t* K, const bf16_t* Vt, bf16_t* O, int bh, int qb, int tid, int wid, int lane) {
    const int r = lane & 31, hh = lane >> 5;
    const int q0 = qb * 256 + wid * 32;
    const bf16_t* Qp = Q + ((size_t)bh * SEQ + q0 + r) * 192 + 8 * hh;
    bf16x8 qf[12];
#pragma unroll
    for (int ks = 0; ks < 12; ++ks) qf[ks] = *(const bf16x8*)(Qp + 16 * ks);
    f32x16 o[4];
#pragma unroll
    for (int dt = 0; dt < 4; ++dt)
#pragma unroll
        for (int i = 0; i < 16; ++i) o[dt][i] = 0.f;
    float m_run = -1e30f, l_run = 0.f;
    const int ntiles = 4 * (qb + 1);
    const bf16_t* Kg = K + (size_t)bh * SEQ * 192; const bf16_t* Vg = Vt + (size_t)bh * 128 * SEQ;
    u32x4 kst[3], vst[2];
#define AT_LOAD(t) do { _Pragma("unroll") for (int i = 0; i < 3; ++i) kst[i] = *((const u32x4*)(Kg + (size_t)(t) * 64 * 192) + tid + 512 * i); \
        _Pragma("unroll") for (int i = 0; i < 2; ++i) { const int c = tid + 512 * i; vst[i] = *(const u32x4*)(Vg + (size_t)(c >> 3) * SEQ + (t) * 64 + (c & 7) * 8); } } while (0)
#define AT_WRITE(buf) do { _Pragma("unroll") for (int i = 0; i < 3; ++i) { const int c = tid + 512 * i; *(LAS u32x4*)(lds + (buf) * AT_BUF + (c / 24) * AT_KROW + (c % 24) * 16) = kst[i]; } \
        _Pragma("unroll") for (int i = 0; i < 2; ++i) { const int c = tid + 512 * i; *(LAS u32x4*)(lds + (buf) * AT_BUF + AT_KBYTES + (c >> 3) * AT_VROW + (c & 7) * 16) = vst[i]; } } while (0)
    AT_LOAD(0); AT_WRITE(0); __syncthreads();
    for (int t = 0; t < ntiles; ++t) {
        if (t + 1 < ntiles) AT_LOAD(t + 1);
        if (64 * t <= q0 + 31) {
            const LAS unsigned char* Kb = lds + (t & 1) * AT_BUF; const LAS unsigned char* Vb = Kb + AT_KBYTES;
            f32x16 s[2];
#pragma unroll
            for (int st = 0; st < 2; ++st) {
#pragma unroll
                for (int i = 0; i < 16; ++i) s[st][i] = 0.f;
#pragma unroll
                for (int kg = 0; kg < 3; ++kg) { bf16x8 a[4];
#pragma unroll
                    for (int k2 = 0; k2 < 4; ++k2) a[k2] = *(const LAS bf16x8*)(Kb + (32 * st + r) * AT_KROW + 32 * (4 * kg + k2) + 16 * hh);
#pragma unroll
                    for (int k2 = 0; k2 < 4; ++k2) s[st] = __builtin_amdgcn_mfma_f32_32x32x16_bf16(a[k2], qf[4 * kg + k2], s[st], 0, 0, 0);
                    __builtin_amdgcn_sched_barrier(0); }
            }
            if (64 * t + 63 > q0) {
                const int qg = q0 + r;
#pragma unroll
                for (int st = 0; st < 2; ++st)
#pragma unroll
                    for (int i = 0; i < 16; ++i) { const int kv = 64 * t + 32 * st + (i & 3) + 8 * (i >> 2) + 4 * hh; if (kv > qg) s[st][i] = -INFINITY; }
            }
            float mx = s[0][0];
#pragma unroll
            for (int st = 0; st < 2; ++st)
#pragma unroll
                for (int i = 0; i < 16; ++i) mx = fmaxf(mx, s[st][i]);
            mx = fmaxf(mx, __shfl_xor(mx, 32));
            const float m_new = fmaxf(m_run, mx); const float alpha = __builtin_amdgcn_exp2f(m_run - m_new); m_run = m_new;
            float ls = 0.f;
#pragma unroll
            for (int st = 0; st < 2; ++st)
#pragma unroll
                for (int i = 0; i < 16; ++i) { s[st][i] = __builtin_amdgcn_exp2f(s[st][i] - m_new); ls += s[st][i]; }
            l_run = l_run * alpha + ls;
#pragma unroll
            for (int dt = 0; dt < 4; ++dt)
#pragma unroll
                for (int i = 0; i < 16; ++i) o[dt][i] *= alpha;
            bf16x8 pf[2][2];
#pragma unroll
            for (int st = 0; st < 2; ++st)
#pragma unroll
                for (int s2 = 0; s2 < 2; ++s2) { u32x4 w; w.x = cvt_pk_bf16(s[st][8 * s2 + 0], s[st][8 * s2 + 1]); w.y = cvt_pk_bf16(s[st][8 * s2 + 2], s[st][8 * s2 + 3]);
                    w.z = cvt_pk_bf16(s[st][8 * s2 + 4], s[st][8 * s2 + 5]); w.w = cvt_pk_bf16(s[st][8 * s2 + 6], s[st][8 * s2 + 7]); pf[st][s2] = __builtin_bit_cast(bf16x8, w); }
#pragma unroll
            for (int dt = 0; dt < 4; ++dt) { bf16x8 a[4];
#pragma unroll
                for (int k2 = 0; k2 < 4; ++k2) a[k2] = *(const LAS bf16x8*)(Vb + (32 * dt + r) * AT_VROW + (16 * k2 + 8 * hh) * 2);
#pragma unroll
                for (int k2 = 0; k2 < 4; ++k2) o[dt] = __builtin_amdgcn_mfma_f32_32x32x16_bf16(a[k2], pf[k2 >> 1][k2 & 1], o[dt], 0, 0, 0);
                __builtin_amdgcn_sched_barrier(0); }
        }
        if (t + 1 < ntiles) AT_WRITE((t + 1) & 1);
        __syncthreads();
    }
#undef AT_LOAD
#undef AT_WRITE
    const float l = l_run + __shfl_xor(l_run, 32); const float inv = 1.f / l;
    const int b = bh >> 4, head = bh & 15;
    bf16_t* op = O + ((size_t)(b * SEQ + q0 + r)) * DM + head * 128 + 4 * hh;
#pragma unroll
    for (int dt = 0; dt < 4; ++dt)
#pragma unroll
        for (int i4 = 0; i4 < 4; ++i4) { u32x2 w; w.x = cvt_pk_bf16(o[dt][4 * i4] * inv, o[dt][4 * i4 + 1] * inv); w.y = cvt_pk_bf16(o[dt][4 * i4 + 2] * inv, o[dt][4 * i4 + 3] * inv);
            *(u32x2*)(op + 32 * dt + 8 * i4) = w; }
}
__device__ __forceinline__ void attn_phase(PP pp, LAS unsigned char* lds, int G, int bid, int tid_in) {
    unsigned char* ws = pp->ws;
    const bf16_t* Q = (const bf16_t*)(ws + S_Q); const bf16_t* K = (const bf16_t*)(ws + S_K); const bf16_t* Vt = (const bf16_t*)(ws + S_VT); bf16_t* O = (bf16_t*)(ws + S_O);
    const int tid = tid_in, wid = __builtin_amdgcn_readfirstlane(tid >> 6), lane = tid & 63;
    for (int pr = bid; pr < 256; pr += G) {
        const int bh = pr >> 2, qa = pr & 3;
        attn_unit(lds, Q, K, Vt, O, bh, 7 - qa, tid, wid, lane);
        attn_unit(lds, Q, K, Vt, O, bh, qa, tid, wid, lane);
    }
}

constexpr int BFS = 132;
constexpr int HG_SEG = 34816, HG_AFTER_SEG = 43008;
__device__ __forceinline__ void hg_cumsum(LAS float* BF, LAS float* SEG, const u32x4 (&lf)[2], int tid) {
#pragma unroll
    for (int i = 0; i < 2; ++i) { const int c = tid + 512 * i; LAS float* d = BF + (c >> 4) * BFS + (c & 15) * 8; const u32x4 w = lf[i];
        *(LAS f32x4*)d = (f32x4){f16_lo(w.x), f16_hi(w.x), f16_lo(w.y), f16_hi(w.y)}; *(LAS f32x4*)(d + 4) = (f32x4){f16_lo(w.z), f16_hi(w.z), f16_lo(w.w), f16_hi(w.w)}; }
    __syncthreads();
    const int d4 = (tid & 31) * 4, sg = tid >> 5;
    f32x4 r[4];
#pragma unroll
    for (int k = 0; k < 4; ++k) r[k] = *(const LAS f32x4*)(BF + (4 * sg + k) * BFS + d4);
    r[1] += r[0]; r[2] += r[1]; r[3] += r[2];
    *(LAS f32x4*)(SEG + sg * 128 + d4) = r[3];
    __syncthreads();
    f32x4 pre = (f32x4){0.f, 0.f, 0.f, 0.f};
#pragma unroll
    for (int s2 = 0; s2 < 15; ++s2) if (s2 < sg) pre += *(const LAS f32x4*)(SEG + s2 * 128 + d4);
#pragma unroll
    for (int k = 0; k < 4; ++k) *(LAS f32x4*)(BF + (4 * sg + k) * BFS + d4) = r[k] + pre;
    __syncthreads();
}
__device__ __forceinline__ void ld8f(const LAS float* p, float (&v)[8]) { const f32x4 a = *(const LAS f32x4*)p, b = *(const LAS f32x4*)(p + 4); v[0] = a[0]; v[1] = a[1]; v[2] = a[2]; v[3] = a[3]; v[4] = b[0]; v[5] = b[1]; v[6] = b[2]; v[7] = b[3]; }
__device__ __forceinline__ void hgrn_phaseA(PP pp, LAS unsigned char* lds, int G, int bid, int tid_in) {
    unsigned char* ws = pp->ws;
    const bf16_t* logf = (const bf16_t*)(ws + S_LOGF); const bf16_t* kk = (const bf16_t*)(ws + S_KK); const bf16_t* vv = (const bf16_t*)(ws + S_V);
    bf16_t* UT = (bf16_t*)(ws + S_UT); float* Gd = (float*)(ws + OFF_G);
    const int tid = tid_in, wid = __builtin_amdgcn_readfirstlane(tid >> 6), lane = tid & 63, fr = lane & 15, fg = lane >> 4;
    LAS float* BF = (LAS float*)lds; LAS float* SEG = (LAS float*)(lds + HG_SEG);
    LAS bf16_t* KhT = (LAS bf16_t*)(lds + HG_AFTER_SEG); LAS bf16_t* vT = (LAS bf16_t*)(lds + HG_AFTER_SEG + 18432);
    const int sp = tid & 31, d8 = (tid >> 5) * 8;
    u32x4 lf[2]; u32x4 vq[2];
#define HA_LOAD(IT) do { const int bh_ = (IT) >> 5, c_ = (IT) & 31; const int r0_ = (bh_ >> 4) * SEQ + c_ * 64, c0_ = (bh_ & 15) * 128; \
        _Pragma("unroll") for (int i = 0; i < 2; ++i) { const int c = tid + 512 * i; lf[i] = *(const u32x4*)(logf + (size_t)(r0_ + (c >> 4)) * DM + c0_ + (c & 15) * 8); } \
        _Pragma("unroll") for (int i = 0; i < 2; ++i) { const size_t o_ = (size_t)(r0_ + 2 * sp + i) * DM + c0_ + d8; vq[i] = *(const u32x4*)(vv + o_); } } while (0)
    int it = bid;
    if (it < 2048) HA_LOAD(it);
    for (; it < 2048; it += G) {
        hg_cumsum(BF, SEG, lf, tid);
        if (tid < 128) Gd[(size_t)it * 128 + tid] = __expf(BF[63 * BFS + tid]);
        { float v0[8], v1[8], bl[8], bm[8], b0[8], b1[8]; unpack8(vq[0], v0); unpack8(vq[1], v1);
          ld8f(BF + 63 * BFS + d8, bl); ld8f(BF + (2 * sp) * BFS + d8, b0); ld8f(BF + (2 * sp + 1) * BFS + d8, b1);
          if (sp > 0) ld8f(BF + (2 * sp - 1) * BFS + d8, bm); else {
#pragma unroll
              for (int j = 0; j < 8; ++j) bm[j] = 0.f; }
#pragma unroll
          for (int j = 0; j < 8; ++j) { const float k0 = 1.f - __expf(b0[j] - bm[j]), k1 = 1.f - __expf(b1[j] - b0[j]);
              *(LAS unsigned*)(KhT + (d8 + j) * 72 + 2 * sp) = cvt_pk_bf16(k0 * __expf(bl[j] - b0[j]), k1 * __expf(bl[j] - b1[j]));
              *(LAS unsigned*)(vT + (d8 + j) * 72 + 2 * sp) = cvt_pk_bf16(v0[j], v1[j]); } }
        __syncthreads();
        if (it + G < 2048) HA_LOAD(it + G);
        f32x4 acc[8];
#pragma unroll
        for (int et = 0; et < 8; ++et) acc[et] = (f32x4){0.f, 0.f, 0.f, 0.f};
#pragma unroll
        for (int ks = 0; ks < 2; ++ks) { const bf16x8 a = *(const LAS bf16x8*)(KhT + (16 * wid + fr) * 72 + 32 * ks + 8 * fg);
#pragma unroll
            for (int et = 0; et < 8; ++et) { const bf16x8 bb = *(const LAS bf16x8*)(vT + (16 * et + fr) * 72 + 32 * ks + 8 * fg); acc[et] = __builtin_amdgcn_mfma_f32_16x16x32_bf16(a, bb, acc[et], 0, 0, 0); } }
        bf16_t* uo = UT + (size_t)it * 16384 + 16 * wid + 4 * fg;
#pragma unroll
        for (int et = 0; et < 8; ++et) { u32x2 w; w.x = pk_f16(acc[et][0], acc[et][1]); w.y = pk_f16(acc[et][2], acc[et][3]); *(u32x2*)(uo + (size_t)(16 * et + fr) * 128) = w; }
        __syncthreads();
    }
#undef HA_LOAD
}
__device__ __forceinline__ void hgrn_phaseB(PP pp, int G, int bid, int tid_in) {
    unsigned char* ws = pp->ws;
    const bf16_t* UT = (const bf16_t*)(ws + S_UT); const float* Gd = (const float*)(ws + OFF_G); bf16_t* SP = (bf16_t*)(ws + S_SP);
    for (int idx = bid * 512 + tid_in; idx < 64 * 128 * 32; idx += G * 512) {
        const int d4 = idx & 31, e = (idx >> 5) & 127, bh = idx >> 12; f32x4 S = (f32x4){0.f, 0.f, 0.f, 0.f};
        for (int c0 = 0; c0 < 32; c0 += 8) {
            f32x4 gq[8]; u32x2 uq[8];
#pragma unroll
            for (int k = 0; k < 8; ++k) { const size_t it = (size_t)bh * 32 + c0 + k; gq[k] = *(const f32x4*)(Gd + it * 128 + 4 * d4); uq[k] = *(const u32x2*)(UT + it * 16384 + e * 128 + 4 * d4); }
#pragma unroll
            for (int k = 0; k < 8; ++k) { const size_t o = ((size_t)bh * 32 + c0 + k) * 16384 + e * 128 + 4 * d4;
                u32x2 w; w.x = cvt_pk_bf16(S[0], S[1]); w.y = cvt_pk_bf16(S[2], S[3]); *(u32x2*)(SP + o) = w;
                S[0] = gq[k][0] * S[0] + f16_lo(uq[k].x); S[1] = gq[k][1] * S[1] + f16_hi(uq[k].x); S[2] = gq[k][2] * S[2] + f16_lo(uq[k].y); S[3] = gq[k][3] * S[3] + f16_hi(uq[k].y); }
        }
    }
}
__device__ __forceinline__ void hgrn_phaseC(PP pp, LAS unsigned char* lds, int G, int bid, int tid_in, int j) {
    unsigned char* ws = pp->ws;
    const bf16_t* logf = (const bf16_t*)(ws + S_LOGF); const bf16_t* kk = (const bf16_t*)(ws + S_KK); const bf16_t* vv = (const bf16_t*)(ws + S_V);
    const bf16_t* qs = (const bf16_t*)(ws + S_QS); const bf16_t* gs = (const bf16_t*)(ws + S_GS); const bf16_t* SP = (const bf16_t*)(ws + S_SP); bf16_t* OG = (bf16_t*)(ws + S_OG);
    const float* onorm = pp->in[16] + j * DM;
    const int tid = tid_in, wid = __builtin_amdgcn_readfirstlane(tid >> 6), lane = tid & 63, fr = lane & 15, fg = lane >> 4;
    LAS float* BF = (LAS float*)lds; LAS bf16_t* SpT = (LAS bf16_t*)lds;
    LAS float* SEG = (LAS float*)(lds + HG_SEG);
    LAS bf16_t* Qh = (LAS bf16_t*)(lds + 43008); LAS bf16_t* Qt = (LAS bf16_t*)(lds + 60416); LAS bf16_t* Kt = (LAS bf16_t*)(lds + 77824);
    LAS bf16_t* vT = (LAS bf16_t*)(lds + 95232);
    LAS bf16_t* Ab = (LAS bf16_t*)(lds + 113664);
    LAS float* SSQ = (LAS float*)(lds + 122880);
    const int sp2 = tid & 31, e8v = (tid >> 5) * 8;
    u32x4 lf[2]; u32x4 q2[2], v2[2], sp[4];
#define HC_LOAD(IT) do { const int bh_ = (IT) >> 5, c_ = (IT) & 31; const int r0_ = (bh_ >> 4) * SEQ + c_ * 64, c0_ = (bh_ & 15) * 128; \
        _Pragma("unroll") for (int i = 0; i < 2; ++i) { const int c = tid + 512 * i; lf[i] = *(const u32x4*)(logf + (size_t)(r0_ + (c >> 4)) * DM + c0_ + (c & 15) * 8); } \
        _Pragma("unroll") for (int i = 0; i < 2; ++i) { const int cx = tid + 512 * i; const size_t o_ = (size_t)(r0_ + (cx >> 4)) * DM + c0_ + (cx & 15) * 8; q2[i] = *(const u32x4*)(qs + o_); \
            v2[i] = *(const u32x4*)(vv + (size_t)(r0_ + 2 * sp2 + i) * DM + c0_ + e8v); } \
        _Pragma("unroll") for (int i = 0; i < 4; ++i) { const int cx = tid + 512 * i; sp[i] = *(const u32x4*)(SP + (size_t)(IT) * 16384 + (cx >> 4) * 128 + (cx & 15) * 8); } } while (0)
    int it = bid;
    if (it < 2048) HC_LOAD(it);
    for (; it < 2048; it += G) {
        const int bh = it >> 5, c = it & 31, b = bh >> 4, head = bh & 15; const int row0 = b * SEQ + c * 64, col0 = head * 128;
        hg_cumsum(BF, SEG, lf, tid);
#pragma unroll
        for (int i = 0; i < 2; ++i) { const int cx = tid + 512 * i, t = cx >> 4, d8 = (cx & 15) * 8; float q8[8], bt[8], bp[8], br[8], a[8], bq[8], ck[8]; unpack8(q2[i], q8);
            ld8f(BF + t * BFS + d8, bt); ld8f(BF + 31 * BFS + d8, br);
            if (t > 0) ld8f(BF + (t - 1) * BFS + d8, bp); else {
#pragma unroll
                for (int jj = 0; jj < 8; ++jj) bp[jj] = 0.f; }
#pragma unroll
            for (int jj = 0; jj < 8; ++jj) { const float k8 = 1.f - __expf(bt[jj] - bp[jj]);
                a[jj] = q8[jj] * __expf(bt[jj]); bq[jj] = q8[jj] * __expf(fminf(bt[jj] - br[jj], 80.f)); ck[jj] = k8 * __expf(fminf(br[jj] - bt[jj], 80.f)); }
            LAS u32x4* d0 = (LAS u32x4*)(Qh + t * 136 + d8); LAS u32x4* d1 = (LAS u32x4*)(Qt + t * 136 + d8); LAS u32x4* d2 = (LAS u32x4*)(Kt + t * 136 + d8);
            u32x4 w; w.x = cvt_pk_bf16(a[0], a[1]); w.y = cvt_pk_bf16(a[2], a[3]); w.z = cvt_pk_bf16(a[4], a[5]); w.w = cvt_pk_bf16(a[6], a[7]); *d0 = w;
            w.x = cvt_pk_bf16(bq[0], bq[1]); w.y = cvt_pk_bf16(bq[2], bq[3]); w.z = cvt_pk_bf16(bq[4], bq[5]); w.w = cvt_pk_bf16(bq[6], bq[7]); *d1 = w;
            w.x = cvt_pk_bf16(ck[0], ck[1]); w.y = cvt_pk_bf16(ck[2], ck[3]); w.z = cvt_pk_bf16(ck[4], ck[5]); w.w = cvt_pk_bf16(ck[6], ck[7]); *d2 = w; }
        { const u32x4 w0 = v2[0], w1 = v2[1];
          LAS unsigned* vd = (LAS unsigned*)(vT + e8v * 72 + 2 * sp2);
          vd[0 * 36] = (w0.x & 0xffffu) | (w1.x << 16); vd[1 * 36] = (w0.x >> 16) | (w1.x & 0xffff0000u); vd[2 * 36] = (w0.y & 0xffffu) | (w1.y << 16); vd[3 * 36] = (w0.y >> 16) | (w1.y & 0xffff0000u);
          vd[4 * 36] = (w0.z & 0xffffu) | (w1.z << 16); vd[5 * 36] = (w0.z >> 16) | (w1.z & 0xffff0000u); vd[6 * 36] = (w0.w & 0xffffu) | (w1.w << 16); vd[7 * 36] = (w0.w >> 16) | (w1.w & 0xffff0000u); }
        __syncthreads();
#pragma unroll
        for (int i = 0; i < 4; ++i) { const int cx = tid + 512 * i, e = cx >> 4, d8 = (cx & 15) * 8; *(LAS u32x4*)(SpT + e * 136 + d8) = sp[i]; }
        const int tt = wid & 3, eh = wid >> 2; const int t = 16 * tt + fr;
        u32x2 gv[4]; f32x4 on[4];
#pragma unroll
        for (int jj = 0; jj < 4; ++jj) { const int e0 = 16 * (4 * eh + jj) + 4 * fg; on[jj] = *(const f32x4*)(onorm + col0 + e0); gv[jj] = *(const u32x2*)(gs + (size_t)(row0 + t) * DM + col0 + e0); }
        if (it + G < 2048) HC_LOAD(it + G);
        { const int sh = wid >> 2; f32x4 a2[2] = {(f32x4){0.f, 0.f, 0.f, 0.f}, (f32x4){0.f, 0.f, 0.f, 0.f}};
#pragma unroll
          for (int ks = 0; ks < 4; ++ks) { const bf16x8 qf = *(const LAS bf16x8*)(Qt + (16 * tt + fr) * 136 + 32 * ks + 8 * fg);
#pragma unroll
              for (int jj = 0; jj < 2; ++jj) { const bf16x8 kf = *(const LAS bf16x8*)(Kt + (16 * (2 * sh + jj) + fr) * 136 + 32 * ks + 8 * fg); a2[jj] = __builtin_amdgcn_mfma_f32_16x16x32_bf16(kf, qf, a2[jj], 0, 0, 0); } }
#pragma unroll
          for (int jj = 0; jj < 2; ++jj) { const int s0 = 16 * (2 * sh + jj) + 4 * fg; u32x2 w;
              w.x = cvt_pk_bf16(s0 + 0 <= t ? a2[jj][0] : 0.f, s0 + 1 <= t ? a2[jj][1] : 0.f); w.y = cvt_pk_bf16(s0 + 2 <= t ? a2[jj][2] : 0.f, s0 + 3 <= t ? a2[jj][3] : 0.f);
              *(LAS u32x2*)(Ab + t * 72 + s0) = w; } }
        __syncthreads();
        { f32x4 acc[4];
#pragma unroll
          for (int jj = 0; jj < 4; ++jj) acc[jj] = (f32x4){0.f, 0.f, 0.f, 0.f};
#pragma unroll
          for (int ks = 0; ks < 4; ++ks) { const bf16x8 qf = *(const LAS bf16x8*)(Qh + (16 * tt + fr) * 136 + 32 * ks + 8 * fg);
#pragma unroll
              for (int jj = 0; jj < 4; ++jj) { const bf16x8 sf = *(const LAS bf16x8*)(SpT + (16 * (4 * eh + jj) + fr) * 136 + 32 * ks + 8 * fg); acc[jj] = __builtin_amdgcn_mfma_f32_16x16x32_bf16(sf, qf, acc[jj], 0, 0, 0); } }
#pragma unroll
          for (int ks = 0; ks < 2; ++ks) { const bf16x8 af = *(const LAS bf16x8*)(Ab + (16 * tt + fr) * 72 + 32 * ks + 8 * fg);
#pragma unroll
              for (int jj = 0; jj < 4; ++jj) { const bf16x8 vf = *(const LAS bf16x8*)(vT + (16 * (4 * eh + jj) + fr) * 72 + 32 * ks + 8 * fg); acc[jj] = __builtin_amdgcn_mfma_f32_16x16x32_bf16(vf, af, acc[jj], 0, 0, 0); } }
          float s2 = 0.f;
#pragma unroll
          for (int jj = 0; jj < 4; ++jj) s2 += dot4(acc[jj]);
          s2 += __shfl_xor(s2, 16); s2 += __shfl_xor(s2, 32);
          if (fg == 0) SSQ[t * 2 + eh] = s2;
          __syncthreads();
          const float rs = rsqrtf((SSQ[t * 2] + SSQ[t * 2 + 1]) * (1.f / 128.f) + EPS);
#pragma unroll
          for (int jj = 0; jj < 4; ++jj) { const int e0 = 16 * (4 * eh + jj) + 4 * fg; u32x2 w;
              w.x = cvt_pk_bf16(acc[jj][0] * rs * on[jj][0] * bf_lo(gv[jj].x), acc[jj][1] * rs * on[jj][1] * bf_hi(gv[jj].x));
              w.y = cvt_pk_bf16(acc[jj][2] * rs * on[jj][2] * bf_lo(gv[jj].y), acc[jj][3] * rs * on[jj][3] * bf_hi(gv[jj].y));
              *(u32x2*)(OG + (size_t)(row0 + t) * DM + col0 + e0) = w; } }
        __syncthreads();
    }
#undef HC_LOAD
}

__device__ __forceinline__ void ffn_fixup(PP pp, int pm, int tid_in, int layer) {
    unsigned char* ws = pp->ws;
    const bf16_t* gate = (const bf16_t*)(ws + S_GATE); const bf16_t* up = (const bf16_t*)(ws + S_UP); bf16_t* act = (bf16_t*)(ws + S_ACT);
    const float* cw = pp->in[19] + (size_t)layer * 3 * DFF; const float* cb = pp->in[20] + (size_t)layer * DFF;
    constexpr int NCH = DFF / 8;
    for (int idx = tid_in; idx < 2 * NCH; idx += 512) {
        const int ch = idx % NCH, sp = idx / NCH; const int col = ch * 8;
        float w0[8], w1[8], w2[8], bb[8];
#pragma unroll
        for (int h = 0; h < 2; ++h) { const f32x4 a = *(const f32x4*)(cw + col + 4 * h), b = *(const f32x4*)(cw + DFF + col + 4 * h), c = *(const f32x4*)(cw + 2 * DFF + col + 4 * h), d = *(const f32x4*)(cb + col + 4 * h);
#pragma unroll
            for (int j = 0; j < 4; ++j) { w0[4 * h + j] = a[j]; w1[4 * h + j] = b[j]; w2[4 * h + j] = c[j]; bb[4 * h + j] = d[j]; } }
        {
            u32x4 gq[2][4], uq[2][2];
#pragma unroll
            for (int s2 = 0; s2 < 2; ++s2) { const int row0 = pm * 256 + (2 * sp + s2) * 64; const bool first = (row0 & 2047) == 0;
                const size_t o0 = (size_t)row0 * DFF + col; const size_t om2 = first ? o0 : o0 - 2 * (size_t)DFF, om1 = first ? o0 : o0 - (size_t)DFF;
                gq[s2][0] = *(const u32x4*)(gate + om2); gq[s2][1] = *(const u32x4*)(gate + om1); gq[s2][2] = *(const u32x4*)(gate + o0); gq[s2][3] = *(const u32x4*)(gate + o0 + DFF);
                uq[s2][0] = *(const u32x4*)(up + o0); uq[s2][1] = *(const u32x4*)(up + o0 + DFF); }
#pragma unroll
            for (int s2 = 0; s2 < 2; ++s2) { const int row0 = pm * 256 + (2 * sp + s2) * 64; const bool first = (row0 & 2047) == 0; const size_t o0 = (size_t)row0 * DFF + col;
                float g0[8], g1[8], g2[8], g3[8], u0[8], u1[8], oa[8], ob[8];
                load8((const bf16_t*)&gq[s2][0], g0); load8((const bf16_t*)&gq[s2][1], g1); load8((const bf16_t*)&gq[s2][2], g2); load8((const bf16_t*)&gq[s2][3], g3);
                load8((const bf16_t*)&uq[s2][0], u0); load8((const bf16_t*)&uq[s2][1], u1);
#pragma unroll
                for (int j = 0; j < 8; ++j) { const float p2 = first ? 0.f : g0[j], p1 = first ? 0.f : g1[j];
                    const float ca = bb[j] + w0[j] * p2 + w1[j] * p1 + w2[j] * g2[j]; oa[j] = ca * sigmoidf_(ca) * u0[j];
                    const float cc = bb[j] + w0[j] * p1 + w1[j] * g2[j] + w2[j] * g3[j]; ob[j] = cc * sigmoidf_(cc) * u1[j]; }
                store8(act + o0, oa); store8(act + o0 + DFF, ob); }
        }
    }
    asm volatile("s_waitcnt vmcnt(0)" ::: "memory");
    __syncthreads();
}

constexpr int NPHASES = 33;
constexpr size_t OFF_BAR = 6 * MiB;
#define XB_TMO      128
#define XB_XCNT(j)  (256  + 64 * (j))
#define XB_XSUB(j)  (1280 + 64 * (j))
#define XB_XGEN(j)  (2304 + 64 * (j))
#define XB_TOP      3328
#define XB_TOPGEN   3392
#define XCD_BAR_WORDS 3456
#define XB_SPIN_CAP (1u << 22)
__device__ __forceinline__ unsigned xb_ld(unsigned* p)              { return __hip_atomic_load(p, __ATOMIC_RELAXED, __HIP_MEMORY_SCOPE_AGENT); }
__device__ __forceinline__ unsigned xb_add(unsigned* p, unsigned v) { return __hip_atomic_fetch_add(p, v, __ATOMIC_RELAXED, __HIP_MEMORY_SCOPE_AGENT); }
__device__ __forceinline__ unsigned xb_xcc_id() { return (unsigned)__builtin_amdgcn_s_getreg((3 << 11) | 20) & 0xFu; }
#define XB_SPIN(cond, bar) do { unsigned _sp = 0; while (cond) { __builtin_amdgcn_s_sleep(1); \
    if ((++_sp & 255u) == 0u) { if (xb_ld(&(bar)[XB_TMO])) break; if (_sp > XB_SPIN_CAP) { atomicAdd(&(bar)[XB_TMO], 1u); break; } } } } while (0)
__device__ __forceinline__ void xcd_barrier_complete(unsigned* bar, unsigned x, unsigned G, unsigned& nloc, unsigned& nx) {
    unsigned sum, cnt, mine, sp = 0u;
    for (;;) {
        sum = 0u; cnt = 0u; mine = 0u;
#pragma unroll
        for (unsigned j = 0; j < 16; ++j) { const unsigned c = xb_ld(&bar[XB_XCNT(j)]); sum += c; cnt += (c > 0u) ? 1u : 0u; mine = (j == x) ? c : mine; }
        if (sum == G) break;
        __builtin_amdgcn_s_sleep(1);
        if ((++sp & 255u) == 0u) { if (xb_ld(&bar[XB_TMO])) break; if (sp > XB_SPIN_CAP) { atomicAdd(&bar[XB_TMO], 1u); break; } }
    }
    nloc = mine > 0u ? mine : 1u; nx = cnt > 0u ? cnt : 1u;
}
__device__ __forceinline__ void grid_barrier(unsigned* bar, volatile LAS unsigned* st, unsigned G, int tid) {
    asm volatile("s_waitcnt vmcnt(0) lgkmcnt(0)" ::: "memory");
    __syncthreads();
    if (tid == 0) {
        const unsigned x = xb_xcc_id();
        __builtin_amdgcn_s_waitcnt(0);
        unsigned nloc = st[0], nx = st[1];
        if (nloc == 0u) { xcd_barrier_complete(bar, x, G, nloc, nx); st[0] = nloc; st[1] = nx; }
        const unsigned old = xb_add(&bar[XB_XSUB(x)], 1u);
        const unsigned gen = old / nloc;
        if (old + 1u == (gen + 1u) * nloc) {
            __builtin_amdgcn_fence(__ATOMIC_RELEASE, "agent");
            asm volatile("s_waitcnt vmcnt(0)" ::: "memory");
            const unsigned og = xb_add(&bar[XB_TOP], 1u);
            const unsigned tg = og / nx;
            if (og + 1u == (tg + 1u) * nx) xb_add(&bar[XB_TOPGEN], 1u);
            else XB_SPIN(xb_ld(&bar[XB_TOPGEN]) == tg, bar);
            __builtin_amdgcn_fence(__ATOMIC_ACQUIRE, "agent");
            xb_add(&bar[XB_XGEN(x)], 1u);
            asm volatile("s_waitcnt vmcnt(0)" ::: "memory");
        } else {
            XB_SPIN(xb_ld(&bar[XB_XGEN(x)]) == gen, bar);
            __builtin_amdgcn_fence(__ATOMIC_ACQUIRE, "agent");
            asm volatile("s_waitcnt vmcnt(0)" ::: "memory");
        }
    }
    __syncthreads();
}
constexpr int LDS_BARST = 131072 + 64;

#define PH_BEGIN(PHI) if ((PHI) >= lo && (PHI) < hi) { constexpr int ph_ = (PHI); PP q = pk; asm volatile("" : "+s"(q)); int G = gridDim.x, bid = (int)__builtin_amdgcn_workgroup_id_x(), wv_ = wid_s; asm volatile("" : "+s"(G), "+s"(bid), "+s"(wv_)); \
        int tid; asm volatile("v_mbcnt_lo_u32_b32 %0, -1, 0\n\tv_mbcnt_hi_u32_b32 %0, -1, %0" : "=&v"(tid)); tid += wv_ * 64; asm volatile("" : "+v"(tid)); \
        unsigned char* ws = q->ws; float* H = q->out; float* ssq = (float*)(ws + OFF_SSQ); \
        bf16_t* hbA = (bf16_t*)(ws + (cur ? OFF_HB1 : OFF_HB0)); bf16_t* hbB = (bf16_t*)(ws + (cur ? OFF_HB0 : OFF_HB1)); bf16_t* hfA = (bf16_t*)(ws + (cur ? OFF_HF1 : OFF_HF0)); bf16_t* hfB = (bf16_t*)(ws + (cur ? OFF_HF0 : OFF_HF1)); (void)H; (void)ssq; (void)hbA; (void)hbB; (void)hfA; (void)hfB; \
        for (int rep_ = 0; rep_ < ((((unsigned long long)(PROBE_MASK) >> ph_) & 1ull) ? 2 : 1); ++rep_) {
#define PH_END } if (ph_ + 1 < hi) { asm volatile("v_mbcnt_lo_u32_b32 %0, -1, 0\n\tv_mbcnt_hi_u32_b32 %0, -1, %0" : "=&v"(tid)); wv_ = wid_s; asm volatile("" : "+s"(wv_)); tid += wv_ * 64; asm volatile("" : "+v"(tid), "+s"(G), "+s"(q)); grid_barrier((unsigned*)(q->ws + OFF_BAR), (volatile LAS unsigned*)(lds + LDS_BARST), (unsigned)G, tid); } }
#define PH_RELOAD asm volatile("v_mbcnt_lo_u32_b32 %0, -1, 0\n\tv_mbcnt_hi_u32_b32 %0, -1, %0" : "=&v"(tid)); wv_ = wid_s; asm volatile("" : "+s"(wv_)); tid += wv_ * 64; asm volatile("" : "+v"(tid), "+s"(G), "+s"(bid), "+s"(q)); ws = q->ws; H = q->out; ssq = (float*)(ws + OFF_SSQ); hbA = (bf16_t*)(ws + (cur ? OFF_HB1 : OFF_HB0)); hbB = (bf16_t*)(ws + (cur ? OFF_HB0 : OFF_HB1)); hfA = (bf16_t*)(ws + (cur ? OFF_HF1 : OFF_HF0)); hfB = (bf16_t*)(ws + (cur ? OFF_HF0 : OFF_HF1));

template <int layer>
__device__ __forceinline__ void run_layer(PP pk, LAS unsigned char* lds, int lo, int hi, int wid_s) {
    constexpr int j = layer >> 1, v = 3 * layer, P0 = 1 + 8 * layer;
    int cur = layer & 1;
    if constexpr ((layer & 1) == 0) {
        PH_BEGIN(P0 + 0) { const bf16_t* Wa = (const bf16_t*)(ws + OFF_WMLA + (size_t)j * 20 * MiB);
            pg8::Gemm g{hfA, Wa, M, CA, DM, DM, DM}; pg8::StaticOrder S; S.init(M, CA, G, bid);
            pg8::EpiBf16S<true> E{(bf16_t*)(ws + S_C), CA, ssq + (size_t)v * M * 32, 1.f / DM, 8, ssq + (size_t)(13 + 2 * j) * M * 32, ssq + (size_t)(14 + 2 * j) * M * 32}; pg8::gemm_phase(lds, g, S, E, tid); }
          PH_RELOAD
          { const int wv = __builtin_amdgcn_readfirstlane(tid >> 6); const int cG = (G == 256) ? 96 : G, cc = (G == 256) ? bid - 160 : bid;
            if (cc >= 0) convert_descs(q, lds, layer == 0 ? 1 : 4, cc * 8 + wv, cG * 8, wv, tid & 63); } PH_END
        PH_BEGIN(P0 + 1) { const bf16_t* Wuq = (const bf16_t*)(ws + OFF_WMLA + (size_t)j * 20 * MiB + 5 * MiB);
            pg8::Gemm g{(const bf16_t*)(ws + S_C), Wuq, M, NQ, 512, CA, 512}; pg8::StaticOrder S; S.init(M, NQ, G, bid);
            pg8::EpiBf16S<false> E{(bf16_t*)(ws + S_QRAW), NQ, ssq + (size_t)(13 + 2 * j) * M * 32, 1.f / 512, 2, nullptr, nullptr}; pg8::gemm_phase(lds, g, S, E, tid); }
          PH_RELOAD
          { const bf16_t* Wukv = (const bf16_t*)(ws + OFF_WMLA + (size_t)j * 20 * MiB + 8 * MiB);
            pg8::Gemm g{(const bf16_t*)(ws + S_C) + 512, Wukv, M, NKV, 512, CA, 512}; pg8::StaticOrder S; S.init(M, NKV, G, bid);
            pg8::EpiBf16S<false> E{(bf16_t*)(ws + S_KVRAW), NKV, ssq + (size_t)(14 + 2 * j) * M * 32, 1.f / 512, 2, nullptr, nullptr}; pg8::gemm_phase(lds, g, S, E, tid); } PH_END
        PH_BEGIN(P0 + 2) mla_prep(q, lds, G, bid, tid, j); PH_END
        PH_BEGIN(P0 + 3) attn_phase(q, lds, G, bid, tid); PH_END
        PH_BEGIN(P0 + 4) { const bf16_t* Wo = (const bf16_t*)(ws + OFF_WMLA + (size_t)j * 20 * MiB + 12 * MiB);
            pg8::Gemm g{(const bf16_t*)(ws + S_O), Wo, M, DM, DM, DM, DM}; pg8::StaticOrder S; S.init(M, DM, G, bid);
            pg8::EpiRes E{layer == 0 ? q->in[0] : nullptr, hfA, hbB, hfB, ssq + (size_t)(v + 1) * M * 32, nullptr}; pg8::gemm_phase(lds, g, S, E, tid); } PH_END
    } else {
        PH_BEGIN(P0 + 0) { const bf16_t* Win = (const bf16_t*)(ws + OFF_WHG + (size_t)j * 40 * MiB);
            pg8::Gemm g{hfA, Win, M, NHG, DM, DM, DM}; pg8::StaticOrder S; S.init(M, NHG, G, bid);
            pg8::EpiHgrnIn E{(bf16_t*)(ws + S_QS), (bf16_t*)(ws + S_LOGF), (bf16_t*)(ws + S_KK), (bf16_t*)(ws + S_V), (bf16_t*)(ws + S_GS), (const float*)(ws + OFF_LB) + layer * DM, ssq + (size_t)v * M * 32, 1.f / DM};
            pg8::gemm_phase(lds, g, S, E, tid); } PH_END
        PH_BEGIN(P0 + 1) hgrn_phaseA(q, lds, G, bid, tid); PH_END
        PH_BEGIN(P0 + 2) hgrn_phaseB(q, G, bid, tid); PH_END
        PH_BEGIN(P0 + 3) hgrn_phaseC(q, lds, G, bid, tid, j); PH_END
        PH_BEGIN(P0 + 4) { const bf16_t* Wo = (const bf16_t*)(ws + OFF_WHG + (size_t)j * 40 * MiB + 32 * MiB);
            pg8::Gemm g{(const bf16_t*)(ws + S_OG), Wo, M, DM, DM, DM, DM}; pg8::StaticOrder S; S.init(M, DM, G, bid);
            pg8::EpiRes E{nullptr, hfA, hbB, hfB, ssq + (size_t)(v + 1) * M * 32, nullptr}; pg8::gemm_phase(lds, g, S, E, tid); } PH_END
    }
    cur ^= 1;
    PH_BEGIN(P0 + 5) { const bf16_t* Wfi = (const bf16_t*)(ws + OFF_W + (size_t)layer * 75 * MiB);
        pg8::Gemm g{hfA, Wfi, M, 2 * DFF, DM, DM, DM}; pg8::StaticOrder S; S.init(M, 2 * DFF, G, bid);
        pg8::EpiFfnIn E{(bf16_t*)(ws + S_GATE), (bf16_t*)(ws + S_UP), (bf16_t*)(ws + S_ACT), ssq + (size_t)(v + 1) * M * 32, 1.f / DM, q->in[19] + (size_t)layer * 3 * DFF, q->in[20] + (size_t)layer * DFF};
        pg8::gemm_phase(lds, g, S, E, tid); }
      PH_RELOAD
      { const int pG = (G == 256) ? 128 : G, pc = (G == 256) ? bid - 128 : bid;
        if (pc >= 0) { const bf16_t* Wpp = (const bf16_t*)(ws + OFF_W + (size_t)layer * 75 * MiB + 74 * MiB);
            pg8::Gemm g{(const bf16_t*)(ws + OFF_PB) + (size_t)layer * M * 256, Wpp, M, DM, 256, 256, 256}; pg8::StaticOrder S; S.init(M, DM, pG, pc);
            pg8::EpiProj E{(bf16_t*)(ws + OFF_PROJ)}; pg8::gemm_phase(lds, g, S, E, tid);
            if (layer < 3) { PH_RELOAD const int wv = __builtin_amdgcn_readfirstlane(tid >> 6); convert_descs(q, lds, layer == 0 ? 2 : (layer == 1 ? 3 : 5), pc * 8 + wv, pG * 8, wv, tid & 63); } } } PH_END
    PH_BEGIN(P0 + 6) { const bf16_t* Wfd = (const bf16_t*)(ws + OFF_W + (size_t)layer * 75 * MiB + 44 * MiB);
        pg8::Gemm g{(const bf16_t*)(ws + S_ACT), Wfd, M, DM, DFF, DFF, DFF}; pg8::StaticOrder S; S.init(M, DM, G, bid);
        { pg8::Unit fu; for (int i = 0; S.next(i, fu); ++i) ffn_fixup(q, fu.pm, tid, layer); }
        PH_RELOAD
        pg8::EpiRes E{nullptr, hfA, hbB, hfB, ssq + (size_t)(v + 2) * M * 32, nullptr}; pg8::gemm_phase(lds, g, S, E, tid); } PH_END
    cur ^= 1;
    PH_BEGIN(P0 + 7)
      { const bf16_t* Wpg = (const bf16_t*)(ws + OFF_W + (size_t)layer * 75 * MiB + 66 * MiB);
        pg8::Gemm g{hfA, Wpg, M, DM, DM, DM, DM}; pg8::StaticOrder S; S.init(M, DM, G, bid);
        pg8::EpiPle E{hfA, hbB, hfB, ssq + (size_t)(v + 3) * M * 32, (const bf16_t*)(ws + OFF_PROJ), ssq + (size_t)(v + 2) * M * 32, 1.f / DM, layer == 3 ? H : nullptr}; pg8::gemm_phase(lds, g, S, E, tid); } PH_END
}

__global__ void __launch_bounds__(512, 2) trunk_fwd(Params p_unused) {
    extern __shared__ __attribute__((aligned(16))) unsigned char lds_raw[];
    LAS unsigned char* lds = (LAS unsigned char*)lds_raw;
    const int wid_s = __builtin_amdgcn_readfirstlane((int)threadIdx.x >> 6);
    PP pk = (PP)__builtin_amdgcn_kernarg_segment_ptr();
    const int lo = pk->ph_lo, hi = pk->ph_hi;
    { int t0 = threadIdx.x; if (t0 == 0) { volatile LAS unsigned* st = (volatile LAS unsigned*)(lds + LDS_BARST); st[0] = 0u; st[1] = 0u;
        if (hi - lo > 1) (void)xb_add(&((unsigned*)(pk->ws + OFF_BAR))[XB_XCNT(xb_xcc_id())], 1u); } __syncthreads(); }
    if (lo < 0) cg::this_grid().sync();
    { const int cur = 0; PH_BEGIN(0) prologue(q, lds, G, bid, tid); PH_END }
    run_layer<0>(pk, lds, lo, hi, wid_s);
    run_layer<1>(pk, lds, lo, hi, wid_s);
    run_layer<2>(pk, lds, lo, hi, wid_s);
    run_layer<3>(pk, lds, lo, hi, wid_s);
}
#undef PH_BEGIN
#undef PH_END
#undef PH_RELOAD

extern "C" void kernel_launch(void* const* d_in, const int* in_sizes, int n_in, void* d_out, int out_size, void* d_ws, size_t ws_size, hipStream_t stream) {
    static int grid = 0;
    if (grid == 0) {
        if (n_in != 24 || out_size != M * DM || ws_size < WS_NEED) { fprintf(stderr, "kernel_launch: unexpected problem (n_in %d, out %d, ws %zu)\n", n_in, out_size, ws_size); grid = -1; return; }
        int dev = 0, cus = 0, per_cu = 0;
        hipGetDevice(&dev); hipDeviceGetAttribute(&cus, hipDeviceAttributeMultiprocessorCount, dev);
        if (hipFuncSetAttribute((const void*)trunk_fwd, hipFuncAttributeMaxDynamicSharedMemorySize, LDS_BYTES) != hipSuccess) { fprintf(stderr, "kernel_launch: hipFuncSetAttribute failed\n"); grid = -1; return; }
        hipOccupancyMaxActiveBlocksPerMultiprocessor(&per_cu, (const void*)trunk_fwd, 512, LDS_BYTES);
        if (per_cu < 1) per_cu = 1;
        grid = cus * 1;
        (void)hipGetLastError();
    }
    if (grid < 0) return;
    Params p{};
    for (int i = 0; i < 24; ++i) p.in[i] = (const float*)d_in[i];
    p.out = (float*)d_out; p.ws = (unsigned char*)d_ws;
    unsigned char* ws = (unsigned char*)d_ws;
    int nd = 0;
    auto add = [&](const float* W, const float* gain, size_t off, int K, int N, int mode, int slot = 0) { mode |= slot << 4; TrDesc& t = p.tr[nd++]; t.W = W; t.gain = gain; t.WT = (bf16_t*)(ws + off); t.K = K; t.N = N; t.ldk = K; t.mode = mode; };
    const float* mixn = p.in[3]; const float* ffnn = p.in[4]; const float* plen = p.in[5];
    for (int j = 0; j < 2; ++j) {
        const size_t wm = OFF_WMLA + (size_t)j * 20 * MiB; const int layer = 2 * j;
        add(p.in[6] + (size_t)j * DM * 1088, mixn + layer * DM, wm, DM, 1088, 2);
        add(p.in[8] + (size_t)j * 512 * NQ, p.in[7] + j * 512, wm + 5 * MiB, 512, NQ, 0);
        add(p.in[10] + (size_t)j * 512 * NKV, p.in[9] + j * 512, wm + 8 * MiB, 512, NKV, 0);
        add(p.in[13] + (size_t)j * DM * DM, nullptr, wm + 12 * MiB, DM, DM, 0, j == 0 ? 0 : 3);
        const size_t wh = OFF_WHG + (size_t)j * 40 * MiB; const int hl = 2 * j + 1;
        add(p.in[15] + (size_t)j * DM * NHG, mixn + hl * DM, wh, DM, NHG, 2, j == 0 ? 1 : 4);
        add(p.in[17] + (size_t)j * DM * DM, nullptr, wh + 32 * MiB, DM, DM, 0, j == 0 ? 2 : 5);
    }
    for (int l = 0; l < 4; ++l) {
        const size_t wl = OFF_W + (size_t)l * 75 * MiB;
        add(p.in[18] + (size_t)l * DM * 2 * DFF, ffnn + l * DM, wl, DM, 2 * DFF, 3);
        add(p.in[21] + (size_t)l * DFF * DM, nullptr, wl + 44 * MiB, DFF, DM, 0, l == 0 ? 0 : (l == 1 ? 2 : (l == 2 ? 3 : 5)));
        add(p.in[23] + (size_t)l * DM * DM, plen + l * DM, wl + 66 * MiB, DM, DM, 2);
        add(p.in[22] + (size_t)l * 256 * DM, nullptr, wl + 74 * MiB, 256, DM, 0);
    }
#if MK_ONE_LAUNCH
    if (hipMemsetAsync(ws + OFF_BAR, 0, 16384, stream) != hipSuccess) fprintf(stderr, "kernel_launch: memset failed\n");
    p.ph_lo = 0; p.ph_hi = NPHASES;
    void* args[] = {&p};
    hipError_t e = hipLaunchCooperativeKernel((const void*)trunk_fwd, dim3(grid), dim3(512), args, LDS_BYTES, stream);
    if (e != hipSuccess) fprintf(stderr, "cooperative launch failed: %s (grid %d)\n", hipGetErrorString(e), grid);
#else
    for (int ph = 0; ph < NPHASES; ++ph) {
        p.ph_lo = ph; p.ph_hi = ph + 1;
        hipLaunchKernelGGL(trunk_fwd, dim3(grid), dim3(512), LDS_BYTES, stream, p);
    }
#endif
}
```

```cpp
#include <hip/hip_runtime.h>
#include <hip/hip_cooperative_groups.h>
#include <cstdio>
#include <cstdint>
namespace cg = cooperative_groups;

#ifndef PROBE_MASK
#define PROBE_MASK 0ull
#endif
#ifndef MK_ONE_LAUNCH
#define MK_ONE_LAUNCH 1
#endif

#define LAS __attribute__((address_space(3)))
typedef unsigned short bf16_t;
typedef short bf16x8 __attribute__((ext_vector_type(8)));
typedef float f32x4 __attribute__((ext_vector_type(4)));
typedef _Float16 f16x8 __attribute__((ext_vector_type(8)));
typedef float f32x16 __attribute__((ext_vector_type(16)));
typedef unsigned u32x4 __attribute__((ext_vector_type(4)));
typedef unsigned u32x2 __attribute__((ext_vector_type(2)));

__device__ __forceinline__ unsigned cvt_pk_bf16(float lo, float hi) { unsigned r; asm volatile("v_cvt_pk_bf16_f32 %0, %1, %2" : "=v"(r) : "v"(lo), "v"(hi)); return r; }
__device__ __forceinline__ float bf_lo(unsigned w) { return __uint_as_float(w << 16); }
__device__ __forceinline__ float bf_hi(unsigned w) { return __uint_as_float(w & 0xffff0000u); }
__device__ __forceinline__ float bf1(bf16_t b) { return __uint_as_float((unsigned)b << 16); }
__device__ __forceinline__ bf16_t f2bf(float f) { return (bf16_t)(cvt_pk_bf16(f, 0.f) & 0xffffu); }
__device__ __forceinline__ unsigned pk_f16(float lo, float hi) { return (unsigned)__builtin_bit_cast(unsigned short, (_Float16)lo) | ((unsigned)__builtin_bit_cast(unsigned short, (_Float16)hi) << 16); }
__device__ __forceinline__ float f16_lo(unsigned w) { return (float)__builtin_bit_cast(_Float16, (unsigned short)(w & 0xffffu)); }
__device__ __forceinline__ float f16_hi(unsigned w) { return (float)__builtin_bit_cast(_Float16, (unsigned short)(w >> 16)); }
__device__ __forceinline__ float sigmoidf_(float x) { return __builtin_amdgcn_rcpf(1.f + __builtin_amdgcn_exp2f(x * -1.4426950408889634f)); }
__device__ __forceinline__ float dot4(f32x4 a) { return (a[0] * a[0] + a[1] * a[1]) + (a[2] * a[2] + a[3] * a[3]); }
__device__ __forceinline__ void atomic_addf(float* p, float v) { (void)__hip_atomic_fetch_add(p, v, __ATOMIC_RELAXED, __HIP_MEMORY_SCOPE_AGENT); }

__device__ __forceinline__ void load8(const bf16_t* p, float (&v)[8]) { const u32x4 w = *(const u32x4*)p; v[0] = bf_lo(w.x); v[1] = bf_hi(w.x); v[2] = bf_lo(w.y); v[3] = bf_hi(w.y); v[4] = bf_lo(w.z); v[5] = bf_hi(w.z); v[6] = bf_lo(w.w); v[7] = bf_hi(w.w); }
__device__ __forceinline__ void unpack8(const u32x4 w, float (&v)[8]) { v[0] = bf_lo(w.x); v[1] = bf_hi(w.x); v[2] = bf_lo(w.y); v[3] = bf_hi(w.y); v[4] = bf_lo(w.z); v[5] = bf_hi(w.z); v[6] = bf_lo(w.w); v[7] = bf_hi(w.w); }
__device__ __forceinline__ void store8(bf16_t* p, const float (&v)[8]) { u32x4 w; w.x = cvt_pk_bf16(v[0], v[1]); w.y = cvt_pk_bf16(v[2], v[3]); w.z = cvt_pk_bf16(v[4], v[5]); w.w = cvt_pk_bf16(v[6], v[7]); *(u32x4*)p = w; }
__device__ __forceinline__ u32x4 pack_f16x8_(const f32x4 a, const f32x4 b) { u32x4 w; w.x = pk_f16(a[0], a[1]); w.y = pk_f16(a[2], a[3]); w.z = pk_f16(b[0], b[1]); w.w = pk_f16(b[2], b[3]); return w; }
constexpr int M = 8192, DM = 2048, SEQ = 2048, NB = 4, NH = 16;
constexpr int DFF = 5632, CA = 1280, NQ = 3072, NKV = 4096, NHG = 8192;
constexpr float EPS = 1e-6f;

namespace pg8 {
constexpr int BM = 256, BK = 64, HALF = 128, HTB = HALF * BK * 2, STAGE_BYTES = 8 * HTB, NXCD = 8, WGM = 8;
__host__ __device__ __forceinline__ int lds_byte(int r, int c) { const int st = (r >> 4) * 2 + (c >> 5), rr = r & 15, cc = c & 31, ob = rr * 64 + cc * 2; return st * 1024 + (ob ^ (((ob >> 9) & 1) << 5)); }
__host__ __device__ __forceinline__ void stage_rc(int b, int& R, int& C) { const int st = b / 1024, sb = b % 1024, swz = sb ^ (((sb >> 9) & 1) << 5); R = (st >> 1) * 16 + swz / 64; C = (st & 1) * 32 + (swz % 64) / 2; }
__host__ __device__ __forceinline__ int perm32(int rho) { const int n = rho >> 4, i = rho & 15; return 8 * (i >> 2) + 4 * n + (i & 3); }

struct Unit { int pm, pn; };
struct Gemm { const bf16_t* A; const bf16_t* Bt; int M, N, K, lda, ldb; };

struct StaticOrder {
    int nM, nN, nwg, G, c;
    __device__ void init(int M_, int N_, int G_, int c_) { nM = M_ / BM; nN = N_ / BM; nwg = nM * nN; G = G_; c = c_; }
    __device__ bool next(int i, Unit& u) const {
        const long L = (long)i * G + c; if (L >= nwg) return false;
        int wgid = (int)L; { const int q = nwg / NXCD, r = nwg % NXCD, xcd = wgid % NXCD, off = wgid / NXCD; wgid = (xcd < r ? xcd * (q + 1) : r * (q + 1) + (xcd - r) * q) + off; }
        const int nig = WGM * nN, gid = wgid / nig, fm = gid * WGM, gsz = (nM - fm) < WGM ? (nM - fm) : WGM;
        u.pm = fm + ((wgid % nig) % gsz); u.pn = (wgid % nig) / gsz; return true;
    }
};

typedef f32x4 Acc[2][2][4][2];
constexpr int LDS_RSTD = 131072 + 1024;
template <class Epi> __device__ __forceinline__ void rstd_issue(const Epi& E, int pm, int tid, f32x4 (&pf)[4]) {
    const f32x4* p = (const f32x4*)(E.ssq_in + (size_t)(pm * BM + (tid >> 1)) * 32); const int half = tid & 1;
    if (E.np4v() == 8) {
#pragma unroll
        for (int k = 0; k < 4; ++k) pf[k] = p[4 * half + k];
    } else { pf[0] = p[half]; pf[1] = (f32x4){0.f, 0.f, 0.f, 0.f}; pf[2] = pf[1]; pf[3] = pf[1]; }
}
template <class Epi> __device__ __forceinline__ void rstd_store(const Epi& E, const f32x4 (&pf)[4], LAS float* tab, int tid) {
    float s = 0.f;
#pragma unroll
    for (int k = 0; k < 4; ++k) s += (pf[k][0] + pf[k][1]) + (pf[k][2] + pf[k][3]);
    s += __shfl_xor(s, 1);
    if ((tid & 1) == 0) tab[tid >> 1] = rsqrtf(s * E.invn + 1e-6f);
}

template <class Epi>
__device__ __forceinline__ void gemm_phase(LAS unsigned char* lds, const Gemm g, const StaticOrder& S, const Epi& E, int tid_in) {
    const int tid = tid_in, wid = __builtin_amdgcn_readfirstlane(tid >> 6), lane = tid & 63, wr = wid >> 2, wc = wid & 3, fr = lane & 15, fq = lane >> 4;
    const int K = g.K, nt = K / BK;
    unsigned voffA[2], voffB[2];
#pragma unroll
    for (int i = 0; i < 2; ++i) { int R, C; stage_rc(tid * 16 + i * 8192, R, C); const int Rb = Epi::PERM ? ((R & ~31) + perm32(R & 31)) : R;
        voffA[i] = (unsigned)(R * g.lda + C) * 2u; voffB[i] = (unsigned)(Rb * g.ldb + C) * 2u; }
    const size_t kstep = (size_t)(BK * 2);
    const size_t hA = (size_t)HALF * g.lda * 2, hB = (size_t)HALF * g.ldb * 2;
    const size_t tA = 2 * hA, tB = 2 * hB;
    const unsigned ldsw = (unsigned)wid * 1024u;
    const int aoff = lds_byte(wr * 64 + fr, fq * 8), boff = lds_byte(wc * 32 + fr, fq * 8);
#define PG8_SA(b, h) (((b) * 2 + (h)) * HTB)
#define PG8_SB(b, h) ((4 + (b) * 2 + (h)) * HTB)
#define PG8_STAGE(bufoff, gbase, voff) do { _Pragma("unroll") for (int _i = 0; _i < 2; ++_i) \
        __builtin_amdgcn_global_load_lds((const unsigned*)((const char*)(gbase) + (voff)[_i]), (LAS unsigned*)(lds + (bufoff) + ldsw + _i * 8192), 16, 0, 0); } while (0)
#define PG8_LDA(dst, b, h) do { _Pragma("unroll") for (int m = 0; m < 4; ++m) _Pragma("unroll") for (int k = 0; k < 2; ++k) dst[m][k] = *(const LAS bf16x8*)(lds + PG8_SA(b, h) + aoff + m * 2048 + k * 1024); } while (0)
#define PG8_LDB(dst, b, h) do { _Pragma("unroll") for (int n = 0; n < 2; ++n) _Pragma("unroll") for (int k = 0; k < 2; ++k) dst[n][k] = *(const LAS bf16x8*)(lds + PG8_SB(b, h) + boff + n * 2048 + k * 1024); } while (0)
#define PG8_MMA(ai, bj, At, Bt) do { __builtin_amdgcn_s_setprio(1); _Pragma("unroll") for (int m = 0; m < 4; ++m) _Pragma("unroll") for (int n = 0; n < 2; ++n) _Pragma("unroll") for (int k = 0; k < 2; ++k) \
        { if constexpr (Epi::F16) acc[ai][bj][m][n] = __builtin_amdgcn_mfma_f32_16x16x32_f16(__builtin_bit_cast(f16x8, Bt[n][k]), __builtin_bit_cast(f16x8, At[m][k]), acc[ai][bj][m][n], 0, 0, 0); \
          else acc[ai][bj][m][n] = __builtin_amdgcn_mfma_f32_16x16x32_bf16(Bt[n][k], At[m][k], acc[ai][bj][m][n], 0, 0, 0); } __builtin_amdgcn_s_setprio(0); } while (0)
#define PG8_WAIT_V(n) asm volatile("s_waitcnt vmcnt(" #n ")" ::: "memory")
#define PG8_WAIT_L(n) asm volatile("s_waitcnt lgkmcnt(" #n ")" ::: "memory")
#define PG8_BAR __builtin_amdgcn_s_barrier()
#define PG8_SCHED __builtin_amdgcn_sched_barrier(0)
    Unit cur, nxt; int ui = 0;
    if (!S.next(0, cur)) return;
    Acc acc;
#pragma unroll
    for (int a = 0; a < 2; ++a)
#pragma unroll
        for (int b = 0; b < 2; ++b)
#pragma unroll
            for (int m = 0; m < 4; ++m)
#pragma unroll
                for (int n = 0; n < 2; ++n) acc[a][b][m][n] = (f32x4){0.f, 0.f, 0.f, 0.f};
    bf16x8 At[4][2], B0[2][2], B1[2][2];
    LAS float* rtab = (LAS float*)(lds + LDS_RSTD);
    f32x4 pf0[4]; if constexpr (Epi::RSTD) rstd_issue(E, cur.pm, tid, pf0);
    const char* cA = (const char*)g.A + (size_t)cur.pm * tA; const char* cB = (const char*)g.Bt + (size_t)cur.pn * tB;
    PG8_STAGE(PG8_SB(0, 0), cB, voffB); PG8_STAGE(PG8_SB(0, 1), cB + hB, voffB); PG8_STAGE(PG8_SA(0, 0), cA, voffA); PG8_STAGE(PG8_SA(0, 1), cA + hA, voffA);
    if (wr == 1) PG8_BAR;
    PG8_WAIT_V(2); PG8_BAR;
    if constexpr (Epi::RSTD) rstd_store(E, pf0, rtab, tid);
    PG8_STAGE(PG8_SB(1, 0), cB + kstep, voffB); PG8_STAGE(PG8_SA(1, 0), cA + kstep, voffA); PG8_STAGE(PG8_SB(1, 1), cB + hB + kstep, voffB);
    PG8_WAIT_V(6); PG8_BAR;
    for (;;) {
        const bool has_next = S.next(ui + 1, nxt);
        const char* nA = has_next ? (const char*)g.A + (size_t)nxt.pm * tA : cA; const char* nB = has_next ? (const char*)g.Bt + (size_t)nxt.pn * tB : cB;
        for (int t = 0; t < nt; t += 2) {
            const bool last = (t == nt - 2);
            const char* a1 = cA + (size_t)(t + 1) * kstep;
            const char* a2 = last ? nA : cA + (size_t)(t + 2) * kstep; const char* b2 = last ? nB : cB + (size_t)(t + 2) * kstep;
            const char* a3 = a2 + kstep; const char* b3 = b2 + kstep;
            PG8_LDB(B0, 0, 0); PG8_LDB(B1, 0, 1); PG8_SCHED; PG8_LDA(At, 0, 0); PG8_STAGE(PG8_SA(1, 1), a1 + hA, voffA);
            PG8_WAIT_V(8); PG8_WAIT_L(0); PG8_BAR; PG8_MMA(0, 0, At, B0); PG8_MMA(0, 1, At, B1); PG8_BAR; PG8_SCHED;
            PG8_LDA(At, 0, 1); PG8_STAGE(PG8_SB(0, 0), b2, voffB); PG8_STAGE(PG8_SB(0, 1), b2 + hB, voffB); PG8_STAGE(PG8_SA(0, 0), a2, voffA);
            PG8_WAIT_V(8); PG8_WAIT_L(0); PG8_BAR; PG8_MMA(1, 0, At, B0); PG8_MMA(1, 1, At, B1); PG8_BAR; PG8_SCHED;
            PG8_LDB(B0, 1, 0); PG8_LDB(B1, 1, 1); PG8_SCHED; PG8_LDA(At, 1, 0); PG8_STAGE(PG8_SA(0, 1), a2 + hA, voffA);
            PG8_WAIT_V(8); PG8_WAIT_L(0); PG8_BAR; PG8_MMA(0, 0, At, B0); PG8_MMA(0, 1, At, B1); PG8_BAR; PG8_SCHED;
            PG8_LDA(At, 1, 1); PG8_STAGE(PG8_SB(1, 0), b3, voffB); PG8_STAGE(PG8_SB(1, 1), b3 + hB, voffB); PG8_STAGE(PG8_SA(1, 0), a3, voffA);
            PG8_WAIT_V(8); PG8_WAIT_L(0); PG8_BAR; PG8_MMA(1, 0, At, B0); PG8_MMA(1, 1, At, B1); PG8_BAR; PG8_SCHED;
        }
        if (wr == 0) PG8_BAR;
        E(acc, cur, wr, wc, fr, fq, rtab + (ui & 1) * 256, has_next ? nxt.pm : -1, rtab + ((ui + 1) & 1) * 256, tid);
        if (!has_next) break;
#pragma unroll
        for (int a = 0; a < 2; ++a)
#pragma unroll
            for (int b = 0; b < 2; ++b)
#pragma unroll
                for (int m = 0; m < 4; ++m)
#pragma unroll
                    for (int n = 0; n < 2; ++n) acc[a][b][m][n] = (f32x4){0.f, 0.f, 0.f, 0.f};
        cur = nxt; cA = nA; cB = nB; ++ui;
        if (wr == 1) PG8_BAR;
    }
    PG8_WAIT_V(0);
    PG8_BAR;
#undef PG8_SA
#undef PG8_SB
#undef PG8_STAGE
#undef PG8_LDA
#undef PG8_LDB
#undef PG8_MMA
#undef PG8_WAIT_V
#undef PG8_WAIT_L
#undef PG8_BAR
#undef PG8_SCHED
}

__device__ __forceinline__ float row_rstd(const float* ssq, int r, float invn, int np4, int fq) {
    if (!ssq) return 1.f;
    const f32x4* p = (const f32x4*)(ssq + (size_t)r * 32); float s = 0.f;
    if (np4 == 8) { const f32x4 a = p[2 * fq], c = p[2 * fq + 1]; s = ((a[0] + a[1]) + (a[2] + a[3])) + ((c[0] + c[1]) + (c[2] + c[3])); }
    else if (fq < 2) { const f32x4 a = p[fq]; s = (a[0] + a[1]) + (a[2] + a[3]); }
    s += __shfl_xor(s, 16); s += __shfl_xor(s, 32);
    return rsqrtf(s * invn + EPS);
}
__device__ __forceinline__ void row_rstd4(const float* ssq, int rowh, float invn, int np4, int fq, float (&rs)[4]) {
    if (!ssq) {
#pragma unroll
        for (int m = 0; m < 4; ++m) rs[m] = 1.f;
        return; }
    float sp[4];
#pragma unroll
    for (int m = 0; m < 4; ++m) { const f32x4* p = (const f32x4*)(ssq + (size_t)(rowh + m * 16) * 32); float s = 0.f;
        if (np4 == 8) { const f32x4 a = p[2 * fq], c = p[2 * fq + 1]; s = ((a[0] + a[1]) + (a[2] + a[3])) + ((c[0] + c[1]) + (c[2] + c[3])); }
        else if (fq < 2) { const f32x4 a = p[fq]; s = (a[0] + a[1]) + (a[2] + a[3]); }
        sp[m] = s; }
#pragma unroll
    for (int m = 0; m < 4; ++m) { float s = sp[m]; s += __shfl_xor(s, 16); s += __shfl_xor(s, 32); rs[m] = rsqrtf(s * invn + EPS); }
}
__device__ __forceinline__ u32x4 pack8(f32x4 a, f32x4 b) { u32x4 w; w.x = cvt_pk_bf16(a[0], a[1]); w.y = cvt_pk_bf16(a[2], a[3]); w.z = cvt_pk_bf16(b[0], b[1]); w.w = cvt_pk_bf16(b[2], b[3]); return w; }

template <bool F16_> struct EpiBf16S {
    static constexpr bool PERM = true, RSTD = true, F16 = F16_;
    __device__ __forceinline__ int np4v() const { return np4; }
    bf16_t* O; int ldc; const float* ssq_in; float invn; int np4; float* ssq0; float* ssq1;
    __device__ __forceinline__ void operator()(const Acc& acc, const Unit& u, int wr, int wc, int fr, int fq, const LAS float* tab, int nxt_pm, LAS float* ntab, int tid) const {
        const int row0 = u.pm * BM + wr * 64 + fr, col0 = u.pn * BM + wc * 32 + 8 * fq;
        float* sq = ssq0 ? (u.pn < 2 ? ssq0 : (u.pn < 4 ? ssq1 : nullptr)) : nullptr;
        f32x4 pf[4]; if (nxt_pm >= 0) rstd_issue(*this, nxt_pm, tid, pf);
#pragma unroll
        for (int ai = 0; ai < 2; ++ai) {
#pragma unroll
            for (int m = 0; m < 4; ++m) { const int r = row0 + ai * HALF + m * 16; const float rs = tab[ai * HALF + wr * 64 + m * 16 + fr]; float part = 0.f;
#pragma unroll
                for (int bj = 0; bj < 2; ++bj) { const f32x4 v0 = acc[ai][bj][m][0] * rs, v1 = acc[ai][bj][m][1] * rs; part += dot4(v0) + dot4(v1);
                    *(u32x4*)(O + (size_t)r * ldc + col0 + bj * HALF) = pack8(v0, v1); }
                if (sq) { part += __shfl_xor(part, 16); part += __shfl_xor(part, 32); if (fq == 0) sq[(size_t)r * 32 + (u.pn & 1) * 4 + wc] = part; } } }
        if (nxt_pm >= 0) rstd_store(*this, pf, ntab, tid);
    }
};
__device__ __forceinline__ float dpp_ror1(float x) { return __builtin_bit_cast(float, __builtin_amdgcn_update_dpp(0, __builtin_bit_cast(int, x), 0x121, 0xf, 0xf, false)); }
__device__ __forceinline__ float dpp_ror2(float x) { return __builtin_bit_cast(float, __builtin_amdgcn_update_dpp(0, __builtin_bit_cast(int, x), 0x122, 0xf, 0xf, false)); }
struct EpiFfnIn {
    static constexpr bool PERM = true, RSTD = true, F16 = true;
    __device__ __forceinline__ int np4v() const { return 8; }
    bf16_t* Gt; bf16_t* Up; bf16_t* Act; const float* ssq_in; float invn; const float* cw; const float* cb;
    __device__ __forceinline__ void operator()(const Acc& acc, const Unit& u, int wr, int wc, int fr, int fq, const LAS float* tab, int nxt_pm, LAS float* ntab, int tid) const {
        const int row0 = u.pm * BM + wr * 64 + fr, col0 = u.pn * HALF + wc * 32 + 8 * fq;
        float w0[8], w1[8], w2[8], bb[8];
#pragma unroll
        for (int h = 0; h < 2; ++h) { const f32x4 a = *(const f32x4*)(cw + col0 + 4 * h), b = *(const f32x4*)(cw + DFF + col0 + 4 * h), c = *(const f32x4*)(cw + 2 * DFF + col0 + 4 * h), d = *(const f32x4*)(cb + col0 + 4 * h);
#pragma unroll
            for (int j = 0; j < 4; ++j) { w0[4 * h + j] = a[j]; w1[4 * h + j] = b[j]; w2[4 * h + j] = c[j]; bb[4 * h + j] = d[j]; } }
        f32x4 pf[4]; if (nxt_pm >= 0) rstd_issue(*this, nxt_pm, tid, pf);
#pragma unroll
        for (int ai = 0; ai < 2; ++ai) {
            float p1[8] = {0.f, 0.f, 0.f, 0.f, 0.f, 0.f, 0.f, 0.f}, p2[8] = {0.f, 0.f, 0.f, 0.f, 0.f, 0.f, 0.f, 0.f};
#pragma unroll
            for (int m = 0; m < 4; ++m) { const int r = row0 + ai * HALF + m * 16; const float rs = tab[ai * HALF + wr * 64 + m * 16 + fr];
                float g[8], up[8], r1[8], r2[8], o[8];
#pragma unroll
                for (int j = 0; j < 4; ++j) { g[j] = acc[ai][0][m][0][j] * rs; g[4 + j] = acc[ai][0][m][1][j] * rs; up[j] = acc[ai][1][m][0][j] * rs; up[4 + j] = acc[ai][1][m][1][j] * rs; }
#pragma unroll
                for (int j = 0; j < 8; ++j) { r1[j] = dpp_ror1(g[j]); r2[j] = dpp_ror2(g[j]); }
                const size_t off = (size_t)r * DFF + col0;
                if (m == 0 && fr < 2) { store8(Gt + off, g); store8(Up + off, up); }
                else {
#pragma unroll
                    for (int j = 0; j < 8; ++j) { const float a1 = (fr >= 1) ? r1[j] : p1[j], a2 = (fr >= 2) ? r2[j] : p2[j]; const float cv = bb[j] + w0[j] * a2 + w1[j] * a1 + w2[j] * g[j]; o[j] = cv * sigmoidf_(cv) * up[j]; }
                    store8(Act + off, o);
                    if (m == 3 && fr >= 14) store8(Gt + off, g);
                }
#pragma unroll
                for (int j = 0; j < 8; ++j) { p1[j] = r1[j]; p2[j] = r2[j]; }
            }
        }
        if (nxt_pm >= 0) rstd_store(*this, pf, ntab, tid);
    }
};
struct EpiHgrnIn {
    static constexpr bool PERM = true, RSTD = true, F16 = true;
    __device__ __forceinline__ int np4v() const { return 8; }
    bf16_t* QS; bf16_t* LOGF; bf16_t* KK; bf16_t* V; bf16_t* GS; const float* lb; const float* ssq_in; float invn;
    __device__ __forceinline__ void operator()(const Acc& acc, const Unit& u, int wr, int wc, int fr, int fq, const LAS float* tab, int nxt_pm, LAS float* ntab, int tid) const {
        const int part = u.pn >> 3;
        const int row0 = u.pm * BM + wr * 64 + fr, col0 = (u.pn & 7) * BM + wc * 32 + 8 * fq;
        f32x4 l0[2], l1[2];
        if (part == 1) {
#pragma unroll
            for (int bj = 0; bj < 2; ++bj) { l0[bj] = *(const f32x4*)(lb + col0 + bj * HALF); l1[bj] = *(const f32x4*)(lb + col0 + bj * HALF + 4); }
        }
        f32x4 pf[4]; if (nxt_pm >= 0) rstd_issue(*this, nxt_pm, tid, pf);
#pragma unroll
        for (int ai = 0; ai < 2; ++ai) {
#pragma unroll
            for (int m = 0; m < 4; ++m) { const int r = row0 + ai * HALF + m * 16; const float rs = tab[ai * HALF + wr * 64 + m * 16 + fr];
#pragma unroll
                for (int bj = 0; bj < 2; ++bj) { f32x4 v0 = acc[ai][bj][m][0] * rs, v1 = acc[ai][bj][m][1] * rs; const size_t o = (size_t)r * DM + col0 + bj * HALF;
                    if (part == 0 || part == 3) {
#pragma unroll
                        for (int j = 0; j < 4; ++j) { v0[j] = v0[j] * sigmoidf_(v0[j]); v1[j] = v1[j] * sigmoidf_(v1[j]); }
                        *(u32x4*)((part == 0 ? QS : GS) + o) = pack8(v0, v1);
                    } else if (part == 2) {
                        *(u32x4*)(V + o) = pack8(v0, v1);
                    } else {
                        f32x4 lf0, lf1;
#pragma unroll
                        for (int j = 0; j < 4; ++j) { const float s0 = sigmoidf_(v0[j]), s1 = sigmoidf_(v1[j]); const float a0 = l0[bj][j], a1 = l1[bj][j];
                            lf0[j] = __logf(a0 + (1.f - a0) * s0); lf1[j] = __logf(a1 + (1.f - a1) * s1); }
                        *(u32x4*)(LOGF + o) = pack_f16x8_(lf0, lf1);
                    } } } }
        if (nxt_pm >= 0) rstd_store(*this, pf, ntab, tid);
    }
};
__device__ __forceinline__ void unpack_f16x8(const u32x4 w, f32x4& a, f32x4& b) { a = (f32x4){f16_lo(w.x), f16_hi(w.x), f16_lo(w.y), f16_hi(w.y)}; b = (f32x4){f16_lo(w.z), f16_hi(w.z), f16_lo(w.w), f16_hi(w.w)}; }
__device__ __forceinline__ u32x4 pack_f16x8(const f32x4 a, const f32x4 b) { u32x4 w; w.x = pk_f16(a[0], a[1]); w.y = pk_f16(a[2], a[3]); w.z = pk_f16(b[0], b[1]); w.w = pk_f16(b[2], b[3]); return w; }
struct EpiRes {
    static constexpr bool PERM = true, RSTD = false, F16 = false;
    const float* base32; const bf16_t* base16; bf16_t* hb; bf16_t* hf; float* ssq_out; float* out32;
    __device__ __forceinline__ void operator()(const Acc& acc, const Unit& u, int wr, int wc, int fr, int fq, const LAS float* tab, int nxt_pm, LAS float* ntab, int tid) const {
        const int row0 = u.pm * BM + wr * 64 + fr, col0 = u.pn * BM + wc * 32 + 8 * fq;
#pragma unroll
        for (int am = 0; am < 4; ++am) { const int ai = am >> 1, mb = (am & 1) * 2;
            f32x4 b0[4][2], b1[4][2];
            if (base32) {
#pragma unroll
                for (int m = mb; m < mb + 2; ++m)
#pragma unroll
                    for (int bj = 0; bj < 2; ++bj) { const float* p = base32 + (size_t)(row0 + ai * HALF + m * 16) * DM + col0 + bj * HALF; b0[m][bj] = *(const f32x4*)p; b1[m][bj] = *(const f32x4*)(p + 4); }
            } else {
                u32x4 bw[4][2];
#pragma unroll
                for (int m = mb; m < mb + 2; ++m)
#pragma unroll
                    for (int bj = 0; bj < 2; ++bj) bw[m][bj] = *(const u32x4*)(base16 + (size_t)(row0 + ai * HALF + m * 16) * DM + col0 + bj * HALF);
#pragma unroll
                for (int m = mb; m < mb + 2; ++m)
#pragma unroll
                    for (int bj = 0; bj < 2; ++bj) unpack_f16x8(bw[m][bj], b0[m][bj], b1[m][bj]);
            }
#pragma unroll
            for (int m = mb; m < mb + 2; ++m) { const int r = row0 + ai * HALF + m * 16; float part = 0.f;
#pragma unroll
                for (int bj = 0; bj < 2; ++bj) { const size_t o = (size_t)r * DM + col0 + bj * HALF;
                    const f32x4 v0 = b0[m][bj] + acc[ai][bj][m][0], v1 = b1[m][bj] + acc[ai][bj][m][1]; part += dot4(v0) + dot4(v1);
                    *(u32x4*)(hf + o) = pack_f16x8(v0, v1);
                    if (out32) { *(f32x4*)(out32 + o) = v0; *(f32x4*)(out32 + o + 4) = v1; } }
                part += __shfl_xor(part, 16); part += __shfl_xor(part, 32); if (fq == 0) ssq_out[(size_t)r * 32 + u.pn * 4 + wc] = part; }
        }
    }
};
struct EpiProj {
    static constexpr bool PERM = true, RSTD = false, F16 = false;
    bf16_t* P;
    __device__ __forceinline__ void operator()(const Acc& acc, const Unit& u, int wr, int wc, int fr, int fq, const LAS float* tab, int nxt_pm, LAS float* ntab, int tid) const {
        const int row0 = u.pm * BM + wr * 64 + fr, col0 = u.pn * BM + wc * 32 + 8 * fq;
#pragma unroll
        for (int ai = 0; ai < 2; ++ai)
#pragma unroll
            for (int m = 0; m < 4; ++m) { const int r = row0 + ai * HALF + m * 16;
#pragma unroll
                for (int bj = 0; bj < 2; ++bj) *(u32x4*)(P + (size_t)r * DM + col0 + bj * HALF) = pack8(acc[ai][bj][m][0], acc[ai][bj][m][1]); }
    }
};
struct EpiPle {
    static constexpr bool PERM = true, RSTD = true, F16 = true;
    __device__ __forceinline__ int np4v() const { return 8; }
    const bf16_t* base16; bf16_t* hb; bf16_t* hf; float* ssq_out; const bf16_t* P; const float* ssq_in; float invn; float* out32;
    __device__ __forceinline__ void operator()(const Acc& acc, const Unit& u, int wr, int wc, int fr, int fq, const LAS float* tab, int nxt_pm, LAS float* ntab, int tid) const {
        const int row0 = u.pm * BM + wr * 64 + fr, col0 = u.pn * BM + wc * 32 + 8 * fq;
#pragma unroll
        for (int am = 0; am < 4; ++am) { const int ai = am >> 1, mb = (am & 1) * 2;
            u32x4 bw[4][2], pv[4][2];
#pragma unroll
            for (int m = mb; m < mb + 2; ++m)
#pragma unroll
                for (int bj = 0; bj < 2; ++bj) { const size_t o = (size_t)(row0 + ai * HALF + m * 16) * DM + col0 + bj * HALF; bw[m][bj] = *(const u32x4*)(base16 + o); pv[m][bj] = *(const u32x4*)(P + o); }
#pragma unroll
            for (int m = mb; m < mb + 2; ++m) { const int r = row0 + ai * HALF + m * 16; const float rs = tab[ai * HALF + wr * 64 + m * 16 + fr]; float part = 0.f;
#pragma unroll
                for (int bj = 0; bj < 2; ++bj) { const size_t o = (size_t)r * DM + col0 + bj * HALF;
                    f32x4 h0, h1; unpack_f16x8(bw[m][bj], h0, h1); const u32x4 pw = pv[m][bj]; const f32x4 a0 = acc[ai][bj][m][0] * rs, a1 = acc[ai][bj][m][1] * rs; f32x4 v0, v1;
                    v0[0] = h0[0] + bf_lo(pw.x) * sigmoidf_(a0[0]); v0[1] = h0[1] + bf_hi(pw.x) * sigmoidf_(a0[1]); v0[2] = h0[2] + bf_lo(pw.y) * sigmoidf_(a0[2]); v0[3] = h0[3] + bf_hi(pw.y) * sigmoidf_(a0[3]);
                    v1[0] = h1[0] + bf_lo(pw.z) * sigmoidf_(a1[0]); v1[1] = h1[1] + bf_hi(pw.z) * sigmoidf_(a1[1]); v1[2] = h1[2] + bf_lo(pw.w) * sigmoidf_(a1[2]); v1[3] = h1[3] + bf_hi(pw.w) * sigmoidf_(a1[3]);
                    part += dot4(v0) + dot4(v1);
                    if (out32) { *(f32x4*)(out32 + o) = v0; *(f32x4*)(out32 + o + 4) = v1; }
                    else *(u32x4*)(hf + o) = pack_f16x8(v0, v1); }
                part += __shfl_xor(part, 16); part += __shfl_xor(part, 32); if (fq == 0) ssq_out[(size_t)r * 32 + u.pn * 4 + wc] = part; }
        }
    }
};
}

constexpr size_t MiB = 1u << 20;
constexpr size_t OFF_SSQ = 956 * MiB;
constexpr size_t OFF_LB = 1 * MiB;
constexpr size_t OFF_ROPE = 2 * MiB;
constexpr size_t OFF_G = 4 * MiB;
constexpr size_t OFF_W = 8 * MiB;
constexpr size_t OFF_WMLA = OFF_W + 300 * MiB;
constexpr size_t OFF_WHG = OFF_W + 340 * MiB;
constexpr size_t OFF_HB0 = 428 * MiB, OFF_HB1 = 460 * MiB;
constexpr size_t OFF_PB = 492 * MiB;
constexpr size_t OFF_PROJ = 508 * MiB;
constexpr size_t OFF_SCR = 540 * MiB;
constexpr size_t OFF_HF0 = 976 * MiB, OFF_HF1 = 1008 * MiB;
constexpr size_t WS_NEED = 1040 * MiB;
constexpr size_t S_C = OFF_SCR, S_QRAW = OFF_SCR + 20 * MiB, S_KVRAW = OFF_SCR + 68 * MiB, S_Q = OFF_SCR + 132 * MiB, S_K = OFF_SCR + 180 * MiB, S_VT = OFF_SCR + 228 * MiB, S_O = OFF_SCR + 260 * MiB;
constexpr size_t S_QS = OFF_SCR, S_LOGF = OFF_SCR + 32 * MiB, S_KK = OFF_SCR + 96 * MiB, S_V = OFF_SCR + 128 * MiB, S_GS = OFF_SCR + 160 * MiB, S_UT = OFF_SCR + 192 * MiB, S_SP = OFF_SCR + 320 * MiB, S_OG = OFF_SCR + 384 * MiB;
constexpr size_t S_GATE = OFF_SCR, S_UP = OFF_SCR + 88 * MiB, S_ACT = OFF_SCR + 176 * MiB;

constexpr int LDS_BYTES = 147456;

struct TrDesc { const float* W; const float* gain; bf16_t* WT; int K, N, ldk, mode; };
struct Params {
    const float* in[24];
    float* out; unsigned char* ws;
    TrDesc tr[28];
    int ph_lo, ph_hi;
};
typedef const __attribute__((address_space(4))) Params* PP;

__device__ __forceinline__ float wave_sum(float v) {
#pragma unroll
    for (int o = 1; o < 64; o <<= 1) v += __shfl_xor(v, o);
    return v;
}

__device__ __forceinline__ void tr_item(const float* W, int N, const float* gain, bf16_t* WT, int ldk, int k0, int n0, int drow0, LAS unsigned* scr, int lane, bool f16) {
    const int kr = lane >> 4, n4 = (lane & 15) * 4;
    f32x4 v[16];
#pragma unroll
    for (int i = 0; i < 8; ++i) { const float* src = W + (size_t)(k0 + 8 * i + 2 * kr) * N + n0 + n4; v[2 * i] = *(const f32x4*)src; v[2 * i + 1] = *(const f32x4*)(src + N); }
#pragma unroll
    for (int i = 0; i < 8; ++i) { const int k = 8 * i + 2 * kr; float g0 = 1.f, g1 = 1.f; if (gain) { g0 = gain[k0 + k]; g1 = gain[k0 + k + 1]; }
#pragma unroll
        for (int j = 0; j < 4; ++j) scr[(n4 + j) * 33 + (k >> 1)] = f16 ? pk_f16(v[2 * i][j] * g0, v[2 * i + 1][j] * g1) : cvt_pk_bf16(v[2 * i][j] * g0, v[2 * i + 1][j] * g1); }
    asm volatile("s_waitcnt lgkmcnt(0)" ::: "memory");
#pragma unroll
    for (int qd = 0; qd < 8; ++qd) { const int c = lane + 64 * qd, n = c >> 3, kc = (c & 7) * 4; const LAS unsigned* sp = scr + n * 33 + kc;
        u32x4 o; o.x = sp[0]; o.y = sp[1]; o.z = sp[2]; o.w = sp[3];
        *(u32x4*)(WT + (size_t)(drow0 + n) * ldk + k0 + 2 * kc) = o; }
    asm volatile("s_waitcnt lgkmcnt(0)" ::: "memory");
}

__device__ __forceinline__ void convert_descs(PP pp, LAS unsigned char* lds, int slot, int gw, int NGW, int wave, int lane) {
    LAS unsigned* scr = (LAS unsigned*)(lds + wave * 16384);
    for (int d = 0; d < 28; ++d) {
        const int mode = pp->tr[d].mode; if ((mode >> 4) != slot) continue;
        const float* W = pp->tr[d].W; const float* gain = pp->tr[d].gain; bf16_t* WT = pp->tr[d].WT; const int K = pp->tr[d].K, N = pp->tr[d].N, ldk = pp->tr[d].ldk;
        const int nblk = N / 64, nitems = (K / 64) * nblk;
        for (int it = gw; it < nitems; it += NGW) {
            const int kb = it / nblk, nb = it % nblk, n0 = nb * 64; int drow0 = n0;
            if (mode & 1) { const int up = n0 >= DFF ? 1 : 0, cc = n0 - up * DFF; drow0 = (cc >> 7) * 256 + up * 128 + (cc & 127); }
            tr_item(W, N, gain, WT, ldk, kb * 64, n0, drow0, scr, lane, (mode & 2) != 0);
        }
    }
}
__device__ __forceinline__ void prologue(PP pp, LAS unsigned char* lds, int G, int bid, int tid_in) {
    const int tid = tid_in, lane = tid & 63, wave = __builtin_amdgcn_readfirstlane(tid >> 6);
    const int gw = bid * 8 + wave, NGW = G * 8;
    const int gt = bid * 512 + tid, NGT = G * 512;
    unsigned char* ws = pp->ws;
    convert_descs(pp, lds, 0, gw, NGW, wave, lane);
    for (int j = 0; j < 2; ++j) { u32x4* z = (u32x4*)(ws + OFF_WMLA + j * 20 * MiB + (size_t)1088 * DM * 2); const int n16 = 192 * DM * 2 / 16;
        for (int i = gt; i < n16; i += NGT) z[i] = (u32x4){0u, 0u, 0u, 0u}; }
    { const float* x = pp->in[0]; bf16_t* hb = (bf16_t*)(ws + OFF_HF0); float* ssq = (float*)(ws + OFF_SSQ);
      for (int r = gw; r < M; r += 2 * NGW) { const int r1 = (r + NGW < M) ? r + NGW : r;
          const f32x4* xa = (const f32x4*)(x + (size_t)r * DM) + lane; const f32x4* xb = (const f32x4*)(x + (size_t)r1 * DM) + lane; f32x4 va[8], vb[8];
#pragma unroll
          for (int j = 0; j < 8; ++j) { va[j] = xa[64 * j]; vb[j] = xb[64 * j]; }
          u32x2* oa = (u32x2*)(hb + (size_t)r * DM) + lane; u32x2* ob = (u32x2*)(hb + (size_t)r1 * DM) + lane; float sa = 0.f, sb = 0.f;
#pragma unroll
          for (int j = 0; j < 8; ++j) { sa += dot4(va[j]); sb += dot4(vb[j]); u32x2 w; w.x = pk_f16(va[j][0], va[j][1]); w.y = pk_f16(va[j][2], va[j][3]); oa[64 * j] = w;
              u32x2 w2; w2.x = pk_f16(vb[j][0], vb[j][1]); w2.y = pk_f16(vb[j][2], vb[j][3]); ob[64 * j] = w2; }
          sa = wave_sum(sa); sb = wave_sum(sb);
          if (lane < 32) { ssq[(size_t)r * 32 + lane] = lane == 0 ? sa : 0.f; ssq[(size_t)r1 * 32 + lane] = lane == 0 ? sb : 0.f; } } }
    { const f32x4* src = (const f32x4*)pp->in[1]; u32x2* dst = (u32x2*)(ws + OFF_PB); const int n4 = 4 * M * 256 / 4;
      for (int i0 = gt; i0 < n4; i0 += 8 * NGT) { f32x4 v[8];
#pragma unroll
          for (int k = 0; k < 8; ++k) { const int i = i0 + k * NGT; v[k] = src[i < n4 ? i : gt]; }
#pragma unroll
          for (int k = 0; k < 8; ++k) { const int i = i0 + k * NGT; if (i < n4) { u32x2 w; w.x = cvt_pk_bf16(v[k][0], v[k][1]); w.y = cvt_pk_bf16(v[k][2], v[k][3]); dst[i] = w; } } } }
    { const float* lg = pp->in[14]; float* lb = (float*)(ws + OFF_LB);
      for (int c = gt; c < DM; c += NGT) { const float a0 = lg[c], a1 = lg[DM + c], a2 = lg[2 * DM + c], a3 = lg[3 * DM + c]; const float mx = fmaxf(fmaxf(a0, a1), fmaxf(a2, a3));
          const float e0 = expf(a0 - mx), e1 = expf(a1 - mx), e2 = expf(a2 - mx), e3 = expf(a3 - mx); const float inv = 1.f / (e0 + e1 + e2 + e3);
          lb[c] = 0.f; lb[DM + c] = e1 * inv; lb[2 * DM + c] = (e1 + e2) * inv; lb[3 * DM + c] = (e1 + e2 + e3) * inv; } }
    { const int* pos = (const int*)pp->in[2]; float* ct = (float*)(ws + OFF_ROPE); float* st = ct + M * 32;
      for (int i = gt; i < M * 32; i += NGT) { const int r = i >> 5, f = i & 31; const float inv = exp2f(-(float)f * (13.287712379549449f / 32.f)); const float ang = (float)pos[r] * inv;
          const double a = (double)ang; const double k = rint(a * 0.15915494309189535); const float rr = (float)(a - k * 6.283185307179586);
          ct[i] = __cosf(rr); st[i] = __sinf(rr); } }
}


__device__ __forceinline__ void norm_rope_192(float (&x)[3][8], const float* gain, const float* ct, const float* st, int sub, float outscale) {
    float ss = 0.f;
#pragma unroll
    for (int g = 0; g < 3; ++g)
#pragma unroll
        for (int j = 0; j < 8; ++j) ss += x[g][j] * x[g][j];
    ss += __shfl_xor(ss, 1); ss += __shfl_xor(ss, 2); ss += __shfl_xor(ss, 4);
    const float rs = rsqrtf(ss * (1.f / 192.f) + EPS);
#pragma unroll
    for (int g = 0; g < 3; ++g) { const f32x4 g0 = *(const f32x4*)(gain + 64 * g + 8 * sub), g1 = *(const f32x4*)(gain + 64 * g + 8 * sub + 4);
#pragma unroll
        for (int j = 0; j < 4; ++j) { x[g][j] = x[g][j] * rs * g0[j]; x[g][4 + j] = x[g][4 + j] * rs * g1[j]; } }
    const int i0 = 8 * (sub & 3);
    const f32x4 c0 = *(const f32x4*)(ct + i0), c1 = *(const f32x4*)(ct + i0 + 4), s0 = *(const f32x4*)(st + i0), s1 = *(const f32x4*)(st + i0 + 4);
#pragma unroll
    for (int j = 0; j < 8; ++j) { const float mine = x[2][j], other = __shfl_xor(mine, 4); const float c = j < 4 ? c0[j & 3] : c1[j & 3], s = j < 4 ? s0[j & 3] : s1[j & 3];
        x[2][j] = (sub < 4) ? (mine * c - other * s) : (mine * c + other * s); }
#pragma unroll
    for (int g = 0; g < 3; ++g)
#pragma unroll
        for (int j = 0; j < 8; ++j) x[g][j] *= outscale;
}

__device__ __forceinline__ void mla_prep(PP pp, LAS unsigned char* lds, int G, int bid, int tid_in, int j) {
    unsigned char* ws = pp->ws;
    const bf16_t* qraw = (const bf16_t*)(ws + S_QRAW); const bf16_t* kvraw = (const bf16_t*)(ws + S_KVRAW); const bf16_t* cc = (const bf16_t*)(ws + S_C);
    bf16_t* Q = (bf16_t*)(ws + S_Q); bf16_t* Kd = (bf16_t*)(ws + S_K); bf16_t* Vt = (bf16_t*)(ws + S_VT);
    const float* gq = pp->in[11] + j * 192; const float* gk = pp->in[12] + j * 192;
    const float* ct = (const float*)(ws + OFF_ROPE); const float* st = ct + M * 32;
    const int tid = tid_in, t = tid >> 3, sub = tid & 7;
    LAS bf16_t* Vl = (LAS bf16_t*)lds;
    const float qscale = 0.07216878364870322f * 1.4426950408889634f;
    for (int it = bid; it < 128 * 16; it += G) {
        const int tb = it >> 4, h = it & 15; const int row = tb * 64 + t, b = row >> 11, s = row & 2047;
        u32x4 rq[3], rk[3], rv[2];
#pragma unroll
        for (int g = 0; g < 3; ++g) rq[g] = *(const u32x4*)(qraw + (size_t)row * NQ + h * 192 + 64 * g + 8 * sub);
#pragma unroll
        for (int g = 0; g < 2; ++g) rk[g] = *(const u32x4*)(kvraw + (size_t)row * NKV + h * 256 + 64 * g + 8 * sub);
        rk[2] = *(const u32x4*)(cc + (size_t)row * CA + 1024 + 8 * sub);
        { const bf16_t* vp = kvraw + (size_t)row * NKV + h * 256 + 128 + 16 * sub; rv[0] = *(const u32x4*)vp; rv[1] = *(const u32x4*)(vp + 8); }
        float x[3][8];
#pragma unroll
        for (int g = 0; g < 3; ++g) unpack8(rq[g], x[g]);
        norm_rope_192(x, gq, ct + row * 32, st + row * 32, sub, qscale);
        bf16_t* qo = Q + ((size_t)(b * NH + h) * SEQ + s) * 192 + 8 * sub;
#pragma unroll
        for (int g = 0; g < 3; ++g) store8(qo + 64 * g, x[g]);
#pragma unroll
        for (int g = 0; g < 3; ++g) unpack8(rk[g], x[g]);
        norm_rope_192(x, gk, ct + row * 32, st + row * 32, sub, 1.f);
        bf16_t* ko = Kd + ((size_t)(b * NH + h) * SEQ + s) * 192 + 8 * sub;
#pragma unroll
        for (int g = 0; g < 3; ++g) store8(ko + 64 * g, x[g]);
        { const u32x4 w0 = rv[0], w1 = rv[1];
          LAS u32x2* d = (LAS u32x2*)(Vl + t * 132 + 16 * sub); d[0] = (u32x2){w0.x, w0.y}; d[1] = (u32x2){w0.z, w0.w}; d[2] = (u32x2){w1.x, w1.y}; d[3] = (u32x2){w1.z, w1.w}; }
        __syncthreads();
        { const int d = tid >> 2, qd = tid & 3; unsigned w[8];
#pragma unroll
          for (int pp = 0; pp < 8; ++pp) { const int p0 = 2 * pp, p1 = 2 * pp + 1; const int o0 = (p0 & 3) | ((p0 & 4) << 1) | ((p0 & 8) >> 1), o1 = (p1 & 3) | ((p1 & 4) << 1) | ((p1 & 8) >> 1);
              w[pp] = (unsigned)Vl[(16 * qd + o0) * 132 + d] | ((unsigned)Vl[(16 * qd + o1) * 132 + d] << 16); }
          bf16_t* vo = Vt + ((size_t)(b * NH + h) * 128 + d) * SEQ + (tb * 64 & 2047) + 16 * qd;
          *(u32x4*)vo = (u32x4){w[0], w[1], w[2], w[3]}; *(u32x4*)(vo + 8) = (u32x4){w[4], w[5], w[6], w[7]}; }
        __syncthreads();
    }
}

constexpr int AT_KROW = 400, AT_VROW = 144, AT_KBYTES = 64 * AT_KROW, AT_BUF = 45056;
__device__ __forceinline__ void attn_unit(LAS unsigned char* lds, const bf16_t* Q, const bf16_t* K, const bf16_t* Vt, bf16_t* O, int bh, int qb, int tid, int wid, int lane) {
    const int r = lane & 31, hh = lane >> 5;
    const int q0 = qb * 256 + wid * 32;
    const bf16_t* Qp = Q + ((size_t)bh * SEQ + q0 + r) * 192 + 8 * hh;
    bf16x8 qf[12];
#pragma unroll
    for (int ks = 0; ks < 12; ++ks) qf[ks] = *(const bf16x8*)(Qp + 16 * ks);
    f32x16 o[4];
#pragma unroll
    for (int dt = 0; dt < 4; ++dt)
#pragma unroll
        for (int i = 0; i < 16; ++i) o[dt][i] = 0.f;
    float m_run = -1e30f, l_run = 0.f;
    const int ntiles = 4 * (qb + 1);
    const bf16_t* Kg = K + (size_t)bh * SEQ * 192; const bf16_t* Vg = Vt + (size_t)bh * 128 * SEQ;
    u32x4 kst[3], vst[2];
#define AT_LOAD(t) do { _Pragma("unroll") for (int i = 0; i < 3; ++i) kst[i] = *((const u32x4*)(Kg + (size_t)(t) * 64 * 192) + tid + 512 * i); \
        _Pragma("unroll") for (int i = 0; i < 2; ++i) { const int c = tid + 512 * i; vst[i] = *(const u32x4*)(Vg + (size_t)(c >> 3) * SEQ + (t) * 64 + (c & 7) * 8); } } while (0)
#define AT_WRITE(buf) do { _Pragma("unroll") for (int i = 0; i < 3; ++i) { const int c = tid + 512 * i; *(LAS u32x4*)(lds + (buf) * AT_BUF + (c / 24) * AT_KROW + (c % 24) * 16) = kst[i]; } \
        _Pragma("unroll") for (int i = 0; i < 2; ++i) { const int c = tid + 512 * i; *(LAS u32x4*)(lds + (buf) * AT_BUF + AT_KBYTES + (c >> 3) * AT_VROW + (c & 7) * 16) = vst[i]; } } while (0)
    AT_LOAD(0); AT_WRITE(0); __syncthreads();
    for (int t = 0; t < ntiles; ++t) {
        if (t + 1 < ntiles) AT_LOAD(t + 1);
        if (64 * t <= q0 + 31) {
            const LAS unsigned char* Kb = lds + (t & 1) * AT_BUF; const LAS unsigned char* Vb = Kb + AT_KBYTES;
            f32x16 s[2];
#pragma unroll
            for (int st = 0; st < 2; ++st) {
#pragma unroll
                for (int i = 0; i < 16; ++i) s[st][i] = 0.f;
#pragma unroll
                for (int kg = 0; kg < 3; ++kg) { bf16x8 a[4];
#pragma unroll
                    for (int k2 = 0; k2 < 4; ++k2) a[k2] = *(const LAS bf16x8*)(Kb + (32 * st + r) * AT_KROW + 32 * (4 * kg + k2) + 16 * hh);
#pragma unroll
                    for (int k2 = 0; k2 < 4; ++k2) s[st] = __builtin_amdgcn_mfma_f32_32x32x16_bf16(a[k2], qf[4 * kg + k2], s[st], 0, 0, 0);
                    __builtin_amdgcn_sched_barrier(0); }
            }
            if (64 * t + 63 > q0) {
                const int qg = q0 + r;
#pragma unroll
                for (int st = 0; st < 2; ++st)
#pragma unroll
                    for (int i = 0; i < 16; ++i) { const int kv = 64 * t + 32 * st + (i & 3) + 8 * (i >> 2) + 4 * hh; if (kv > qg) s[st][i] = -INFINITY; }
            }
            float mx = s[0][0];
#pragma unroll
            for (int st = 0; st < 2; ++st)
#pragma unroll
                for (int i = 0; i < 16; ++i) mx = fmaxf(mx, s[st][i]);
            mx = fmaxf(mx, __shfl_xor(mx, 32));
            const float m_new = fmaxf(m_run, mx); const float alpha = __builtin_amdgcn_exp2f(m_run - m_new); m_run = m_new;
            float ls = 0.f;
#pragma unroll
            for (int st = 0; st < 2; ++st)
#pragma unroll
                for (int i = 0; i < 16; ++i) { s[st][i] = __builtin_amdgcn_exp2f(s[st][i] - m_new); ls += s[st][i]; }
            l_run = l_run * alpha + ls;
#pragma unroll
            for (int dt = 0; dt < 4; ++dt)
#pragma unroll
                for (int i = 0; i < 16; ++i) o[dt][i] *= alpha;
            bf16x8 pf[2][2];
#pragma unroll
            for (int st = 0; st < 2; ++st)
#pragma unroll
                for (int s2 = 0; s2 < 2; ++s2) { u32x4 w; w.x = cvt_pk_bf16(s[st][8 * s2 + 0], s[st][8 * s2 + 1]); w.y = cvt_pk_bf16(s[st][8 * s2 + 2], s[st][8 * s2 + 3]);
                    w.z = cvt_pk_bf16(s[st][8 * s2 + 4], s[st][8 * s2 + 5]); w.w = cvt_pk_bf16(s[st][8 * s2 + 6], s[st][8 * s2 + 7]); pf[st][s2] = __builtin_bit_cast(bf16x8, w); }
#pragma unroll
            for (int dt = 0; dt < 4; ++dt) { bf16x8 a[4];
#pragma unroll
                for (int k2 = 0; k2 < 4; ++k2) a[k2] = *(const LAS bf16x8*)(Vb + (32 * dt + r) * AT_VROW + (16 * k2 + 8 * hh) * 2);
#pragma unroll
                for (int k2 = 0; k2 < 4; ++k2) o[dt] = __builtin_amdgcn_mfma_f32_32x32x16_bf16(a[k2], pf[k2 >> 1][k2 & 1], o[dt], 0, 0, 0);
                __builtin_amdgcn_sched_barrier(0); }
        }
        if (t + 1 < ntiles) AT_WRITE((t + 1) & 1);
        __syncthreads();
    }
#undef AT_LOAD
#undef AT_WRITE
    const float l = l_run + __shfl_xor(l_run, 32); const float inv = 1.f / l;
    const int b = bh >> 4, head = bh & 15;
    bf16_t* op = O + ((size_t)(b * SEQ + q0 + r)) * DM + head * 128 + 4 * hh;
#pragma unroll
    for (int dt = 0; dt < 4; ++dt)
#pragma unroll
        for (int i4 = 0; i4 < 4; ++i4) { u32x2 w; w.x = cvt_pk_bf16(o[dt][4 * i4] * inv, o[dt][4 * i4 + 1] * inv); w.y = cvt_pk_bf16(o[dt][4 * i4 + 2] * inv, o[dt][4 * i4 + 3] * inv);
            *(u32x2*)(op + 32 * dt + 8 * i4) = w; }
}
__device__ __forceinline__ void attn_phase(PP pp, LAS unsigned char* lds, int G, int bid, int tid_in) {
    unsigned char* ws = pp->ws;
    const bf16_t* Q = (const bf16_t*)(ws + S_Q); const bf16_t* K = (const bf16_t*)(ws + S_K); const bf16_t* Vt = (const bf16_t*)(ws + S_VT); bf16_t* O = (bf16_t*)(ws + S_O);
    const int tid = tid_in, wid = __builtin_amdgcn_readfirstlane(tid >> 6), lane = tid & 63;
    for (int pr = bid; pr < 256; pr += G) {
        const int bh = pr >> 2, qa = pr & 3;
        attn_unit(lds, Q, K, Vt, O, bh, 7 - qa, tid, wid, lane);
        attn_unit(lds, Q, K, Vt, O, bh, qa, tid, wid, lane);
    }
}

constexpr int BFS = 132;
constexpr int HG_SEG = 34816, HG_AFTER_SEG = 43008;
__device__ __forceinline__ void hg_cumsum(LAS float* BF, LAS float* SEG, const u32x4 (&lf)[2], int tid) {
#pragma unroll
    for (int i = 0; i < 2; ++i) { const int c = tid + 512 * i; LAS float* d = BF + (c >> 4) * BFS + (c & 15) * 8; const u32x4 w = lf[i];
        *(LAS f32x4*)d = (f32x4){f16_lo(w.x), f16_hi(w.x), f16_lo(w.y), f16_hi(w.y)}; *(LAS f32x4*)(d + 4) = (f32x4){f16_lo(w.z), f16_hi(w.z), f16_lo(w.w), f16_hi(w.w)}; }
    __syncthreads();
    const int d4 = (tid & 31) * 4, sg = tid >> 5;
    f32x4 r[4];
#pragma unroll
    for (int k = 0; k < 4; ++k) r[k] = *(const LAS f32x4*)(BF + (4 * sg + k) * BFS + d4);
    r[1] += r[0]; r[2] += r[1]; r[3] += r[2];
    *(LAS f32x4*)(SEG + sg * 128 + d4) = r[3];
    __syncthreads();
    f32x4 pre = (f32x4){0.f, 0.f, 0.f, 0.f};
#pragma unroll
    for (int s2 = 0; s2 < 15; ++s2) if (s2 < sg) pre += *(const LAS f32x4*)(SEG + s2 * 128 + d4);
#pragma unroll
    for (int k = 0; k < 4; ++k) *(LAS f32x4*)(BF + (4 * sg + k) * BFS + d4) = r[k] + pre;
    __syncthreads();
}
__device__ __forceinline__ void ld8f(const LAS float* p, float (&v)[8]) { const f32x4 a = *(const LAS f32x4*)p, b = *(const LAS f32x4*)(p + 4); v[0] = a[0]; v[1] = a[1]; v[2] = a[2]; v[3] = a[3]; v[4] = b[0]; v[5] = b[1]; v[6] = b[2]; v[7] = b[3]; }
__device__ __forceinline__ void hgrn_phaseA(PP pp, LAS unsigned char* lds, int G, int bid, int tid_in) {
    unsigned char* ws = pp->ws;
    const bf16_t* logf = (const bf16_t*)(ws + S_LOGF); const bf16_t* kk = (const bf16_t*)(ws + S_KK); const bf16_t* vv = (const bf16_t*)(ws + S_V);
    bf16_t* UT = (bf16_t*)(ws + S_UT); float* Gd = (float*)(ws + OFF_G);
    const int tid = tid_in, wid = __builtin_amdgcn_readfirstlane(tid >> 6), lane = tid & 63, fr = lane & 15, fg = lane >> 4;
    LAS float* BF = (LAS float*)lds; LAS float* SEG = (LAS float*)(lds + HG_SEG);
    LAS bf16_t* KhT = (LAS bf16_t*)(lds + HG_AFTER_SEG); LAS bf16_t* vT = (LAS bf16_t*)(lds + HG_AFTER_SEG + 18432);
    const int sp = tid & 31, d8 = (tid >> 5) * 8;
    u32x4 lf[2]; u32x4 vq[2];
#define HA_LOAD(IT) do { const int bh_ = (IT) >> 5, c_ = (IT) & 31; const int r0_ = (bh_ >> 4) * SEQ + c_ * 64, c0_ = (bh_ & 15) * 128; \
        _Pragma("unroll") for (int i = 0; i < 2; ++i) { const int c = tid + 512 * i; lf[i] = *(const u32x4*)(logf + (size_t)(r0_ + (c >> 4)) * DM + c0_ + (c & 15) * 8); } \
        _Pragma("unroll") for (int i = 0; i < 2; ++i) { const size_t o_ = (size_t)(r0_ + 2 * sp + i) * DM + c0_ + d8; vq[i] = *(const u32x4*)(vv + o_); } } while (0)
    int it = bid;
    if (it < 2048) HA_LOAD(it);
    for (; it < 2048; it += G) {
        hg_cumsum(BF, SEG, lf, tid);
        if (tid < 128) Gd[(size_t)it * 128 + tid] = __expf(BF[63 * BFS + tid]);
        { float v0[8], v1[8], bl[8], bm[8], b0[8], b1[8]; unpack8(vq[0], v0); unpack8(vq[1], v1);
          ld8f(BF + 63 * BFS + d8, bl); ld8f(BF + (2 * sp) * BFS + d8, b0); ld8f(BF + (2 * sp + 1) * BFS + d8, b1);
          if (sp > 0) ld8f(BF + (2 * sp - 1) * BFS + d8, bm); else {
#pragma unroll
              for (int j = 0; j < 8; ++j) bm[j] = 0.f; }
#pragma unroll
          for (int j = 0; j < 8; ++j) { const float k0 = 1.f - __expf(b0[j] - bm[j]), k1 = 1.f - __expf(b1[j] - b0[j]);
              *(LAS unsigned*)(KhT + (d8 + j) * 72 + 2 * sp) = cvt_pk_bf16(k0 * __expf(bl[j] - b0[j]), k1 * __expf(bl[j] - b1[j]));
              *(LAS unsigned*)(vT + (d8 + j) * 72 + 2 * sp) = cvt_pk_bf16(v0[j], v1[j]); } }
        __syncthreads();
        if (it + G < 2048) HA_LOAD(it + G);
        f32x4 acc[8];
#pragma unroll
        for (int et = 0; et < 8; ++et) acc[et] = (f32x4){0.f, 0.f, 0.f, 0.f};
#pragma unroll
        for (int ks = 0; ks < 2; ++ks) { const bf16x8 a = *(const LAS bf16x8*)(KhT + (16 * wid + fr) * 72 + 32 * ks + 8 * fg);
#pragma unroll
            for (int et = 0; et < 8; ++et) { const bf16x8 bb = *(const LAS bf16x8*)(vT + (16 * et + fr) * 72 + 32 * ks + 8 * fg); acc[et] = __builtin_amdgcn_mfma_f32_16x16x32_bf16(a, bb, acc[et], 0, 0, 0); } }
        bf16_t* uo = UT + (size_t)it * 16384 + 16 * wid + 4 * fg;
#pragma unroll
        for (int et = 0; et < 8; ++et) { u32x2 w; w.x = pk_f16(acc[et][0], acc[et][1]); w.y = pk_f16(acc[et][2], acc[et][3]); *(u32x2*)(uo + (size_t)(16 * et + fr) * 128) = w; }
        __syncthreads();
    }
#undef HA_LOAD
}
__device__ __forceinline__ void hgrn_phaseB(PP pp, int G, int bid, int tid_in) {
    unsigned char* ws = pp->ws;
    const bf16_t* UT = (const bf16_t*)(ws + S_UT); const float* Gd = (const float*)(ws + OFF_G); bf16_t* SP = (bf16_t*)(ws + S_SP);
    for (int idx = bid * 512 + tid_in; idx < 64 * 128 * 32; idx += G * 512) {
        const int d4 = idx & 31, e = (idx >> 5) & 127, bh = idx >> 12; f32x4 S = (f32x4){0.f, 0.f, 0.f, 0.f};
        for (int c0 = 0; c0 < 32; c0 += 16) {
            f32x4 gq[16]; u32x2 uq[16];
#pragma unroll
            for (int k = 0; k < 16; ++k) { const size_t it = (size_t)bh * 32 + c0 + k; gq[k] = *(const f32x4*)(Gd + it * 128 + 4 * d4); uq[k] = *(const u32x2*)(UT + it * 16384 + e * 128 + 4 * d4); }
#pragma unroll
            for (int k = 0; k < 16; ++k) { const size_t o = ((size_t)bh * 32 + c0 + k) * 16384 + e * 128 + 4 * d4;
                u32x2 w; w.x = cvt_pk_bf16(S[0], S[1]); w.y = cvt_pk_bf16(S[2], S[3]); *(u32x2*)(SP + o) = w;
                S[0] = gq[k][0] * S[0] + f16_lo(uq[k].x); S[1] = gq[k][1] * S[1] + f16_hi(uq[k].x); S[2] = gq[k][2] * S[2] + f16_lo(uq[k].y); S[3] = gq[k][3] * S[3] + f16_hi(uq[k].y); }
        }
    }
}
__device__ __forceinline__ void hgrn_phaseC(PP pp, LAS unsigned char* lds, int G, int bid, int tid_in, int j) {
    unsigned char* ws = pp->ws;
    const bf16_t* logf = (const bf16_t*)(ws + S_LOGF); const bf16_t* kk = (const bf16_t*)(ws + S_KK); const bf16_t* vv = (const bf16_t*)(ws + S_V);
    const bf16_t* qs = (const bf16_t*)(ws + S_QS); const bf16_t* gs = (const bf16_t*)(ws + S_GS); const bf16_t* SP = (const bf16_t*)(ws + S_SP); bf16_t* OG = (bf16_t*)(ws + S_OG);
    const float* onorm = pp->in[16] + j * DM;
    const int tid = tid_in, wid = __builtin_amdgcn_readfirstlane(tid >> 6), lane = tid & 63, fr = lane & 15, fg = lane >> 4;
    LAS float* BF = (LAS float*)lds; LAS bf16_t* SpT = (LAS bf16_t*)lds;
    LAS float* SEG = (LAS float*)(lds + HG_SEG);
    LAS bf16_t* Qh = (LAS bf16_t*)(lds + 43008); LAS bf16_t* Qt = (LAS bf16_t*)(lds + 60416); LAS bf16_t* Kt = (LAS bf16_t*)(lds + 77824);
    LAS bf16_t* vT = (LAS bf16_t*)(lds + 95232);
    LAS bf16_t* Ab = (LAS bf16_t*)(lds + 113664);
    LAS float* SSQ = (LAS float*)(lds + 122880);
    const int sp2 = tid & 31, e8v = (tid >> 5) * 8;
    u32x4 lf[2]; u32x4 q2[2], v2[2], sp[4];
#define HC_LOAD(IT) do { const int bh_ = (IT) >> 5, c_ = (IT) & 31; const int r0_ = (bh_ >> 4) * SEQ + c_ * 64, c0_ = (bh_ & 15) * 128; \
        _Pragma("unroll") for (int i = 0; i < 2; ++i) { const int c = tid + 512 * i; lf[i] = *(const u32x4*)(logf + (size_t)(r0_ + (c >> 4)) * DM + c0_ + (c & 15) * 8); } \
        _Pragma("unroll") for (int i = 0; i < 2; ++i) { const int cx = tid + 512 * i; const size_t o_ = (size_t)(r0_ + (cx >> 4)) * DM + c0_ + (cx & 15) * 8; q2[i] = *(const u32x4*)(qs + o_); \
            v2[i] = *(const u32x4*)(vv + (size_t)(r0_ + 2 * sp2 + i) * DM + c0_ + e8v); } \
        _Pragma("unroll") for (int i = 0; i < 4; ++i) { const int cx = tid + 512 * i; sp[i] = *(const u32x4*)(SP + (size_t)(IT) * 16384 + (cx >> 4) * 128 + (cx & 15) * 8); } } while (0)
    int it = bid;
    if (it < 2048) HC_LOAD(it);
    for (; it < 2048; it += G) {
        const int bh = it >> 5, c = it & 31, b = bh >> 4, head = bh & 15; const int row0 = b * SEQ + c * 64, col0 = head * 128;
        hg_cumsum(BF, SEG, lf, tid);
#pragma unroll
        for (int i = 0; i < 2; ++i) { const int cx = tid + 512 * i, t = cx >> 4, d8 = (cx & 15) * 8; float q8[8], bt[8], bp[8], br[8], a[8], bq[8], ck[8]; unpack8(q2[i], q8);
            ld8f(BF + t * BFS + d8, bt); ld8f(BF + 31 * BFS + d8, br);
            if (t > 0) ld8f(BF + (t - 1) * BFS + d8, bp); else {
#pragma unroll
                for (int jj = 0; jj < 8; ++jj) bp[jj] = 0.f; }
#pragma unroll
            for (int jj = 0; jj < 8; ++jj) { const float k8 = 1.f - __expf(bt[jj] - bp[jj]);
                a[jj] = q8[jj] * __expf(bt[jj]); bq[jj] = q8[jj] * __expf(fminf(bt[jj] - br[jj], 80.f)); ck[jj] = k8 * __expf(fminf(br[jj] - bt[jj], 80.f)); }
            LAS u32x4* d0 = (LAS u32x4*)(Qh + t * 136 + d8); LAS u32x4* d1 = (LAS u32x4*)(Qt + t * 136 + d8); LAS u32x4* d2 = (LAS u32x4*)(Kt + t * 136 + d8);
            u32x4 w; w.x = cvt_pk_bf16(a[0], a[1]); w.y = cvt_pk_bf16(a[2], a[3]); w.z = cvt_pk_bf16(a[4], a[5]); w.w = cvt_pk_bf16(a[6], a[7]); *d0 = w;
            w.x = cvt_pk_bf16(bq[0], bq[1]); w.y = cvt_pk_bf16(bq[2], bq[3]); w.z = cvt_pk_bf16(bq[4], bq[5]); w.w = cvt_pk_bf16(bq[6], bq[7]); *d1 = w;
            w.x = cvt_pk_bf16(ck[0], ck[1]); w.y = cvt_pk_bf16(ck[2], ck[3]); w.z = cvt_pk_bf16(ck[4], ck[5]); w.w = cvt_pk_bf16(ck[6], ck[7]); *d2 = w; }
        { const u32x4 w0 = v2[0], w1 = v2[1];
          LAS unsigned* vd = (LAS unsigned*)(vT + e8v * 72 + 2 * sp2);
          vd[0 * 36] = (w0.x & 0xffffu) | (w1.x << 16); vd[1 * 36] = (w0.x >> 16) | (w1.x & 0xffff0000u); vd[2 * 36] = (w0.y & 0xffffu) | (w1.y << 16); vd[3 * 36] = (w0.y >> 16) | (w1.y & 0xffff0000u);
          vd[4 * 36] = (w0.z & 0xffffu) | (w1.z << 16); vd[5 * 36] = (w0.z >> 16) | (w1.z & 0xffff0000u); vd[6 * 36] = (w0.w & 0xffffu) | (w1.w << 16); vd[7 * 36] = (w0.w >> 16) | (w1.w & 0xffff0000u); }
        __syncthreads();
#pragma unroll
        for (int i = 0; i < 4; ++i) { const int cx = tid + 512 * i, e = cx >> 4, d8 = (cx & 15) * 8; *(LAS u32x4*)(SpT + e * 136 + d8) = sp[i]; }
        const int tt = wid & 3, eh = wid >> 2; const int t = 16 * tt + fr;
        u32x2 gv[4]; f32x4 on[4];
#pragma unroll
        for (int jj = 0; jj < 4; ++jj) { const int e0 = 16 * (4 * eh + jj) + 4 * fg; on[jj] = *(const f32x4*)(onorm + col0 + e0); gv[jj] = *(const u32x2*)(gs + (size_t)(row0 + t) * DM + col0 + e0); }
        if (it + G < 2048) HC_LOAD(it + G);
        { const int sh = wid >> 2; f32x4 a2[2] = {(f32x4){0.f, 0.f, 0.f, 0.f}, (f32x4){0.f, 0.f, 0.f, 0.f}};
#pragma unroll
          for (int ks = 0; ks < 4; ++ks) { const bf16x8 qf = *(const LAS bf16x8*)(Qt + (16 * tt + fr) * 136 + 32 * ks + 8 * fg);
#pragma unroll
              for (int jj = 0; jj < 2; ++jj) { const bf16x8 kf = *(const LAS bf16x8*)(Kt + (16 * (2 * sh + jj) + fr) * 136 + 32 * ks + 8 * fg); a2[jj] = __builtin_amdgcn_mfma_f32_16x16x32_bf16(kf, qf, a2[jj], 0, 0, 0); } }
#pragma unroll
          for (int jj = 0; jj < 2; ++jj) { const int s0 = 16 * (2 * sh + jj) + 4 * fg; u32x2 w;
              w.x = cvt_pk_bf16(s0 + 0 <= t ? a2[jj][0] : 0.f, s0 + 1 <= t ? a2[jj][1] : 0.f); w.y = cvt_pk_bf16(s0 + 2 <= t ? a2[jj][2] : 0.f, s0 + 3 <= t ? a2[jj][3] : 0.f);
              *(LAS u32x2*)(Ab + t * 72 + s0) = w; } }
        __syncthreads();
        { f32x4 acc[4];
#pragma unroll
          for (int jj = 0; jj < 4; ++jj) acc[jj] = (f32x4){0.f, 0.f, 0.f, 0.f};
#pragma unroll
          for (int ks = 0; ks < 4; ++ks) { const bf16x8 qf = *(const LAS bf16x8*)(Qh + (16 * tt + fr) * 136 + 32 * ks + 8 * fg);
#pragma unroll
              for (int jj = 0; jj < 4; ++jj) { const bf16x8 sf = *(const LAS bf16x8*)(SpT + (16 * (4 * eh + jj) + fr) * 136 + 32 * ks + 8 * fg); acc[jj] = __builtin_amdgcn_mfma_f32_16x16x32_bf16(sf, qf, acc[jj], 0, 0, 0); } }
#pragma unroll
          for (int ks = 0; ks < 2; ++ks) { const bf16x8 af = *(const LAS bf16x8*)(Ab + (16 * tt + fr) * 72 + 32 * ks + 8 * fg);
#pragma unroll
              for (int jj = 0; jj < 4; ++jj) { const bf16x8 vf = *(const LAS bf16x8*)(vT + (16 * (4 * eh + jj) + fr) * 72 + 32 * ks + 8 * fg); acc[jj] = __builtin_amdgcn_mfma_f32_16x16x32_bf16(vf, af, acc[jj], 0, 0, 0); } }
          float s2 = 0.f;
#pragma unroll
          for (int jj = 0; jj < 4; ++jj) s2 += dot4(acc[jj]);
          s2 += __shfl_xor(s2, 16); s2 += __shfl_xor(s2, 32);
          if (fg == 0) SSQ[t * 2 + eh] = s2;
          __syncthreads();
          const float rs = rsqrtf((SSQ[t * 2] + SSQ[t * 2 + 1]) * (1.f / 128.f) + EPS);
#pragma unroll
          for (int jj = 0; jj < 4; ++jj) { const int e0 = 16 * (4 * eh + jj) + 4 * fg; u32x2 w;
              w.x = cvt_pk_bf16(acc[jj][0] * rs * on[jj][0] * bf_lo(gv[jj].x), acc[jj][1] * rs * on[jj][1] * bf_hi(gv[jj].x));
              w.y = cvt_pk_bf16(acc[jj][2] * rs * on[jj][2] * bf_lo(gv[jj].y), acc[jj][3] * rs * on[jj][3] * bf_hi(gv[jj].y));
              *(u32x2*)(OG + (size_t)(row0 + t) * DM + col0 + e0) = w; } }
        __syncthreads();
    }
#undef HC_LOAD
}

__device__ __forceinline__ void ffn_fixup(PP pp, int pm, int tid_in, int layer) {
    unsigned char* ws = pp->ws;
    const bf16_t* gate = (const bf16_t*)(ws + S_GATE); const bf16_t* up = (const bf16_t*)(ws + S_UP); bf16_t* act = (bf16_t*)(ws + S_ACT);
    const float* cw = pp->in[19] + (size_t)layer * 3 * DFF; const float* cb = pp->in[20] + (size_t)layer * DFF;
    constexpr int NCH = DFF / 8;
    for (int idx = tid_in; idx < 2 * NCH; idx += 512) {
        const int ch = idx % NCH, sp = idx / NCH; const int col = ch * 8;
        float w0[8], w1[8], w2[8], bb[8];
#pragma unroll
        for (int h = 0; h < 2; ++h) { const f32x4 a = *(const f32x4*)(cw + col + 4 * h), b = *(const f32x4*)(cw + DFF + col + 4 * h), c = *(const f32x4*)(cw + 2 * DFF + col + 4 * h), d = *(const f32x4*)(cb + col + 4 * h);
#pragma unroll
            for (int j = 0; j < 4; ++j) { w0[4 * h + j] = a[j]; w1[4 * h + j] = b[j]; w2[4 * h + j] = c[j]; bb[4 * h + j] = d[j]; } }
        {
            u32x4 gq[2][4], uq[2][2];
#pragma unroll
            for (int s2 = 0; s2 < 2; ++s2) { const int row0 = pm * 256 + (2 * sp + s2) * 64; const bool first = (row0 & 2047) == 0;
                const size_t o0 = (size_t)row0 * DFF + col; const size_t om2 = first ? o0 : o0 - 2 * (size_t)DFF, om1 = first ? o0 : o0 - (size_t)DFF;
                gq[s2][0] = *(const u32x4*)(gate + om2); gq[s2][1] = *(const u32x4*)(gate + om1); gq[s2][2] = *(const u32x4*)(gate + o0); gq[s2][3] = *(const u32x4*)(gate + o0 + DFF);
                uq[s2][0] = *(const u32x4*)(up + o0); uq[s2][1] = *(const u32x4*)(up + o0 + DFF); }
#pragma unroll
            for (int s2 = 0; s2 < 2; ++s2) { const int row0 = pm * 256 + (2 * sp + s2) * 64; const bool first = (row0 & 2047) == 0; const size_t o0 = (size_t)row0 * DFF + col;
                float g0[8], g1[8], g2[8], g3[8], u0[8], u1[8], oa[8], ob[8];
                load8((const bf16_t*)&gq[s2][0], g0); load8((const bf16_t*)&gq[s2][1], g1); load8((const bf16_t*)&gq[s2][2], g2); load8((const bf16_t*)&gq[s2][3], g3);
                load8((const bf16_t*)&uq[s2][0], u0); load8((const bf16_t*)&uq[s2][1], u1);
#pragma unroll
                for (int j = 0; j < 8; ++j) { const float p2 = first ? 0.f : g0[j], p1 = first ? 0.f : g1[j];
                    const float ca = bb[j] + w0[j] * p2 + w1[j] * p1 + w2[j] * g2[j]; oa[j] = ca * sigmoidf_(ca) * u0[j];
                    const float cc = bb[j] + w0[j] * p1 + w1[j] * g2[j] + w2[j] * g3[j]; ob[j] = cc * sigmoidf_(cc) * u1[j]; }
                store8(act + o0, oa); store8(act + o0 + DFF, ob); }
        }
    }
    asm volatile("s_waitcnt vmcnt(0)" ::: "memory");
    __syncthreads();
}

constexpr int NPHASES = 33;
constexpr size_t OFF_BAR = 6 * MiB;
#define XB_TMO      128
#define XB_XCNT(j)  (256  + 64 * (j))
#define XB_XSUB(j)  (1280 + 64 * (j))
#define XB_XGEN(j)  (2304 + 64 * (j))
#define XB_TOP      3328
#define XB_TOPGEN   3392
#define XCD_BAR_WORDS 3456
#define XB_SPIN_CAP (1u << 22)
__device__ __forceinline__ unsigned xb_ld(unsigned* p)              { return __hip_atomic_load(p, __ATOMIC_RELAXED, __HIP_MEMORY_SCOPE_AGENT); }
__device__ __forceinline__ unsigned xb_add(unsigned* p, unsigned v) { return __hip_atomic_fetch_add(p, v, __ATOMIC_RELAXED, __HIP_MEMORY_SCOPE_AGENT); }
__device__ __forceinline__ unsigned xb_xcc_id() { return (unsigned)__builtin_amdgcn_s_getreg((3 << 11) | 20) & 0xFu; }
#define XB_SPIN(cond, bar) do { unsigned _sp = 0; while (cond) { __builtin_amdgcn_s_sleep(1); \
    if ((++_sp & 255u) == 0u) { if (xb_ld(&(bar)[XB_TMO])) break; if (_sp > XB_SPIN_CAP) { atomicAdd(&(bar)[XB_TMO], 1u); break; } } } } while (0)
__device__ __forceinline__ void xcd_barrier_complete(unsigned* bar, unsigned x, unsigned G, unsigned& nloc, unsigned& nx) {
    unsigned sum, cnt, mine, sp = 0u;
    for (;;) {
        sum = 0u; cnt = 0u; mine = 0u;
#pragma unroll
        for (unsigned j = 0; j < 16; ++j) { const unsigned c = xb_ld(&bar[XB_XCNT(j)]); sum += c; cnt += (c > 0u) ? 1u : 0u; mine = (j == x) ? c : mine; }
        if (sum == G) break;
        __builtin_amdgcn_s_sleep(1);
        if ((++sp & 255u) == 0u) { if (xb_ld(&bar[XB_TMO])) break; if (sp > XB_SPIN_CAP) { atomicAdd(&bar[XB_TMO], 1u); break; } }
    }
    nloc = mine > 0u ? mine : 1u; nx = cnt > 0u ? cnt : 1u;
}
__device__ __forceinline__ void grid_barrier(unsigned* bar, volatile LAS unsigned* st, unsigned G, int tid) {
    asm volatile("s_waitcnt vmcnt(0) lgkmcnt(0)" ::: "memory");
    __syncthreads();
    if (tid == 0) {
        const unsigned x = xb_xcc_id();
        __builtin_amdgcn_s_waitcnt(0);
        unsigned nloc = st[0], nx = st[1];
        if (nloc == 0u) { xcd_barrier_complete(bar, x, G, nloc, nx); st[0] = nloc; st[1] = nx; }
        const unsigned old = xb_add(&bar[XB_XSUB(x)], 1u);
        const unsigned gen = old / nloc;
        if (old + 1u == (gen + 1u) * nloc) {
            __builtin_amdgcn_fence(__ATOMIC_RELEASE, "agent");
            asm volatile("s_waitcnt vmcnt(0)" ::: "memory");
            const unsigned og = xb_add(&bar[XB_TOP], 1u);
            const unsigned tg = og / nx;
            if (og + 1u == (tg + 1u) * nx) xb_add(&bar[XB_TOPGEN], 1u);
            else XB_SPIN(xb_ld(&bar[XB_TOPGEN]) == tg, bar);
            __builtin_amdgcn_fence(__ATOMIC_ACQUIRE, "agent");
            xb_add(&bar[XB_XGEN(x)], 1u);
            asm volatile("s_waitcnt vmcnt(0)" ::: "memory");
        } else {
            XB_SPIN(xb_ld(&bar[XB_XGEN(x)]) == gen, bar);
            __builtin_amdgcn_fence(__ATOMIC_ACQUIRE, "agent");
            asm volatile("s_waitcnt vmcnt(0)" ::: "memory");
        }
    }
    __syncthreads();
}
constexpr int LDS_BARST = 131072 + 64;

#define PH_BEGIN(PHI) if ((PHI) >= lo && (PHI) < hi) { constexpr int ph_ = (PHI); PP q = pk; asm volatile("" : "+s"(q)); int G = gridDim.x, bid = (int)__builtin_amdgcn_workgroup_id_x(), wv_ = wid_s; asm volatile("" : "+s"(G), "+s"(bid), "+s"(wv_)); \
        int tid; asm volatile("v_mbcnt_lo_u32_b32 %0, -1, 0\n\tv_mbcnt_hi_u32_b32 %0, -1, %0" : "=&v"(tid)); tid += wv_ * 64; asm volatile("" : "+v"(tid)); \
        unsigned char* ws = q->ws; float* H = q->out; float* ssq = (float*)(ws + OFF_SSQ); \
        bf16_t* hbA = (bf16_t*)(ws + (cur ? OFF_HB1 : OFF_HB0)); bf16_t* hbB = (bf16_t*)(ws + (cur ? OFF_HB0 : OFF_HB1)); bf16_t* hfA = (bf16_t*)(ws + (cur ? OFF_HF1 : OFF_HF0)); bf16_t* hfB = (bf16_t*)(ws + (cur ? OFF_HF0 : OFF_HF1)); (void)H; (void)ssq; (void)hbA; (void)hbB; (void)hfA; (void)hfB; \
        for (int rep_ = 0; rep_ < ((((unsigned long long)(PROBE_MASK) >> ph_) & 1ull) ? 2 : 1); ++rep_) {
#define PH_END } if (ph_ + 1 < hi) { asm volatile("v_mbcnt_lo_u32_b32 %0, -1, 0\n\tv_mbcnt_hi_u32_b32 %0, -1, %0" : "=&v"(tid)); wv_ = wid_s; asm volatile("" : "+s"(wv_)); tid += wv_ * 64; asm volatile("" : "+v"(tid), "+s"(G), "+s"(q)); grid_barrier((unsigned*)(q->ws + OFF_BAR), (volatile LAS unsigned*)(lds + LDS_BARST), (unsigned)G, tid); } }
#define PH_RELOAD asm volatile("v_mbcnt_lo_u32_b32 %0, -1, 0\n\tv_mbcnt_hi_u32_b32 %0, -1, %0" : "=&v"(tid)); wv_ = wid_s; asm volatile("" : "+s"(wv_)); tid += wv_ * 64; asm volatile("" : "+v"(tid), "+s"(G), "+s"(bid), "+s"(q)); ws = q->ws; H = q->out; ssq = (float*)(ws + OFF_SSQ); hbA = (bf16_t*)(ws + (cur ? OFF_HB1 : OFF_HB0)); hbB = (bf16_t*)(ws + (cur ? OFF_HB0 : OFF_HB1)); hfA = (bf16_t*)(ws + (cur ? OFF_HF1 : OFF_HF0)); hfB = (bf16_t*)(ws + (cur ? OFF_HF0 : OFF_HF1));

template <int layer>
__device__ __forceinline__ void run_layer(PP pk, LAS unsigned char* lds, int lo, int hi, int wid_s) {
    constexpr int j = layer >> 1, v = 3 * layer, P0 = 1 + 8 * layer;
    int cur = layer & 1;
    if constexpr ((layer & 1) == 0) {
        PH_BEGIN(P0 + 0) { const bf16_t* Wa = (const bf16_t*)(ws + OFF_WMLA + (size_t)j * 20 * MiB);
            pg8::Gemm g{hfA, Wa, M, CA, DM, DM, DM}; pg8::StaticOrder S; S.init(M, CA, G, bid);
            pg8::EpiBf16S<true> E{(bf16_t*)(ws + S_C), CA, ssq + (size_t)v * M * 32, 1.f / DM, 8, ssq + (size_t)(13 + 2 * j) * M * 32, ssq + (size_t)(14 + 2 * j) * M * 32}; pg8::gemm_phase(lds, g, S, E, tid); }
          PH_RELOAD
          { const int wv = __builtin_amdgcn_readfirstlane(tid >> 6); const int cG = (G == 256) ? 96 : G, cc = (G == 256) ? bid - 160 : bid;
            if (cc >= 0) convert_descs(q, lds, layer == 0 ? 1 : 4, cc * 8 + wv, cG * 8, wv, tid & 63); } PH_END
        PH_BEGIN(P0 + 1) { const bf16_t* Wuq = (const bf16_t*)(ws + OFF_WMLA + (size_t)j * 20 * MiB + 5 * MiB);
            pg8::Gemm g{(const bf16_t*)(ws + S_C), Wuq, M, NQ, 512, CA, 512}; pg8::StaticOrder S; S.init(M, NQ, G, bid);
            pg8::EpiBf16S<false> E{(bf16_t*)(ws + S_QRAW), NQ, ssq + (size_t)(13 + 2 * j) * M * 32, 1.f / 512, 2, nullptr, nullptr}; pg8::gemm_phase(lds, g, S, E, tid); }
          PH_RELOAD
          { const bf16_t* Wukv = (const bf16_t*)(ws + OFF_WMLA + (size_t)j * 20 * MiB + 8 * MiB);
            pg8::Gemm g{(const bf16_t*)(ws + S_C) + 512, Wukv, M, NKV, 512, CA, 512}; pg8::StaticOrder S; S.init(M, NKV, G, bid);
            pg8::EpiBf16S<false> E{(bf16_t*)(ws + S_KVRAW), NKV, ssq + (size_t)(14 + 2 * j) * M * 32, 1.f / 512, 2, nullptr, nullptr}; pg8::gemm_phase(lds, g, S, E, tid); } PH_END
        PH_BEGIN(P0 + 2) mla_prep(q, lds, G, bid, tid, j); PH_END
        PH_BEGIN(P0 + 3) attn_phase(q, lds, G, bid, tid); PH_END
        PH_BEGIN(P0 + 4) { const bf16_t* Wo = (const bf16_t*)(ws + OFF_WMLA + (size_t)j * 20 * MiB + 12 * MiB);
            pg8::Gemm g{(const bf16_t*)(ws + S_O), Wo, M, DM, DM, DM, DM}; pg8::StaticOrder S; S.init(M, DM, G, bid);
            pg8::EpiRes E{layer == 0 ? q->in[0] : nullptr, hfA, hbB, hfB, ssq + (size_t)(v + 1) * M * 32, nullptr}; pg8::gemm_phase(lds, g, S, E, tid); } PH_END
    } else {
        PH_BEGIN(P0 + 0) { const bf16_t* Win = (const bf16_t*)(ws + OFF_WHG + (size_t)j * 40 * MiB);
            pg8::Gemm g{hfA, Win, M, NHG, DM, DM, DM}; pg8::StaticOrder S; S.init(M, NHG, G, bid);
            pg8::EpiHgrnIn E{(bf16_t*)(ws + S_QS), (bf16_t*)(ws + S_LOGF), (bf16_t*)(ws + S_KK), (bf16_t*)(ws + S_V), (bf16_t*)(ws + S_GS), (const float*)(ws + OFF_LB) + layer * DM, ssq + (size_t)v * M * 32, 1.f / DM};
            pg8::gemm_phase(lds, g, S, E, tid); } PH_END
        PH_BEGIN(P0 + 1) hgrn_phaseA(q, lds, G, bid, tid); PH_END
        PH_BEGIN(P0 + 2) hgrn_phaseB(q, G, bid, tid); PH_END
        PH_BEGIN(P0 + 3) hgrn_phaseC(q, lds, G, bid, tid, j); PH_END
        PH_BEGIN(P0 + 4) { const bf16_t* Wo = (const bf16_t*)(ws + OFF_WHG + (size_t)j * 40 * MiB + 32 * MiB);
            pg8::Gemm g{(const bf16_t*)(ws + S_OG), Wo, M, DM, DM, DM, DM}; pg8::StaticOrder S; S.init(M, DM, G, bid);
            pg8::EpiRes E{nullptr, hfA, hbB, hfB, ssq + (size_t)(v + 1) * M * 32, nullptr}; pg8::gemm_phase(lds, g, S, E, tid); } PH_END
    }
    cur ^= 1;
    PH_BEGIN(P0 + 5) { const bf16_t* Wfi = (const bf16_t*)(ws + OFF_W + (size_t)layer * 75 * MiB);
        pg8::Gemm g{hfA, Wfi, M, 2 * DFF, DM, DM, DM}; pg8::StaticOrder S; S.init(M, 2 * DFF, G, bid);
        pg8::EpiFfnIn E{(bf16_t*)(ws + S_GATE), (bf16_t*)(ws + S_UP), (bf16_t*)(ws + S_ACT), ssq + (size_t)(v + 1) * M * 32, 1.f / DM, q->in[19] + (size_t)layer * 3 * DFF, q->in[20] + (size_t)layer * DFF};
        pg8::gemm_phase(lds, g, S, E, tid); }
      PH_RELOAD
      { const int pG = (G == 256) ? 128 : G, pc = (G == 256) ? bid - 128 : bid;
        if (pc >= 0) { const bf16_t* Wpp = (const bf16_t*)(ws + OFF_W + (size_t)layer * 75 * MiB + 74 * MiB);
            pg8::Gemm g{(const bf16_t*)(ws + OFF_PB) + (size_t)layer * M * 256, Wpp, M, DM, 256, 256, 256}; pg8::StaticOrder S; S.init(M, DM, pG, pc);
            pg8::EpiProj E{(bf16_t*)(ws + OFF_PROJ)}; pg8::gemm_phase(lds, g, S, E, tid);
            if (layer < 3) { PH_RELOAD const int wv = __builtin_amdgcn_readfirstlane(tid >> 6); convert_descs(q, lds, layer == 0 ? 2 : (layer == 1 ? 3 : 5), pc * 8 + wv, pG * 8, wv, tid & 63); } } } PH_END
    PH_BEGIN(P0 + 6) { const bf16_t* Wfd = (const bf16_t*)(ws + OFF_W + (size_t)layer * 75 * MiB + 44 * MiB);
        pg8::Gemm g{(const bf16_t*)(ws + S_ACT), Wfd, M, DM, DFF, DFF, DFF}; pg8::StaticOrder S; S.init(M, DM, G, bid);
        { pg8::Unit fu; for (int i = 0; S.next(i, fu); ++i) ffn_fixup(q, fu.pm, tid, layer); }
        PH_RELOAD
        pg8::EpiRes E{nullptr, hfA, hbB, hfB, ssq + (size_t)(v + 2) * M * 32, nullptr}; pg8::gemm_phase(lds, g, S, E, tid); } PH_END
    cur ^= 1;
    PH_BEGIN(P0 + 7)
      { const bf16_t* Wpg = (const bf16_t*)(ws + OFF_W + (size_t)layer * 75 * MiB + 66 * MiB);
        pg8::Gemm g{hfA, Wpg, M, DM, DM, DM, DM}; pg8::StaticOrder S; S.init(M, DM, G, bid);
        pg8::EpiPle E{hfA, hbB, hfB, ssq + (size_t)(v + 3) * M * 32, (const bf16_t*)(ws + OFF_PROJ), ssq + (size_t)(v + 2) * M * 32, 1.f / DM, layer == 3 ? H : nullptr}; pg8::gemm_phase(lds, g, S, E, tid); } PH_END
}

__global__ void __launch_bounds__(512, 2) trunk_fwd(Params p_unused) {
    extern __shared__ __attribute__((aligned(16))) unsigned char lds_raw[];
    LAS unsigned char* lds = (LAS unsigned char*)lds_raw;
    const int wid_s = __builtin_amdgcn_readfirstlane((int)threadIdx.x >> 6);
    PP pk = (PP)__builtin_amdgcn_kernarg_segment_ptr();
    const int lo = pk->ph_lo, hi = pk->ph_hi;
    { int t0 = threadIdx.x; if (t0 == 0) { volatile LAS unsigned* st = (volatile LAS unsigned*)(lds + LDS_BARST); st[0] = 0u; st[1] = 0u;
        if (hi - lo > 1) (void)xb_add(&((unsigned*)(pk->ws + OFF_BAR))[XB_XCNT(xb_xcc_id())], 1u); } __syncthreads(); }
    if (lo < 0) cg::this_grid().sync();
    { const int cur = 0; PH_BEGIN(0) prologue(q, lds, G, bid, tid); PH_END }
    run_layer<0>(pk, lds, lo, hi, wid_s);
    run_layer<1>(pk, lds, lo, hi, wid_s);
    run_layer<2>(pk, lds, lo, hi, wid_s);
    run_layer<3>(pk, lds, lo, hi, wid_s);
}
#undef PH_BEGIN
#undef PH_END
#undef PH_RELOAD

extern "C" void kernel_launch(void* const* d_in, const int* in_sizes, int n_in, void* d_out, int out_size, void* d_ws, size_t ws_size, hipStream_t stream) {
    static int grid = 0;
    if (grid == 0) {
        if (n_in != 24 || out_size != M * DM || ws_size < WS_NEED) { fprintf(stderr, "kernel_launch: unexpected problem (n_in %d, out %d, ws %zu)\n", n_in, out_size, ws_size); grid = -1; return; }
        int dev = 0, cus = 0, per_cu = 0;
        hipGetDevice(&dev); hipDeviceGetAttribute(&cus, hipDeviceAttributeMultiprocessorCount, dev);
        if (hipFuncSetAttribute((const void*)trunk_fwd, hipFuncAttributeMaxDynamicSharedMemorySize, LDS_BYTES) != hipSuccess) { fprintf(stderr, "kernel_launch: hipFuncSetAttribute failed\n"); grid = -1; return; }
        hipOccupancyMaxActiveBlocksPerMultiprocessor(&per_cu, (const void*)trunk_fwd, 512, LDS_BYTES);
        if (per_cu < 1) per_cu = 1;
        grid = cus * 1;
        (void)hipGetLastError();
    }
    if (grid < 0) return;
    Params p{};
    for (int i = 0; i < 24; ++i) p.in[i] = (const float*)d_in[i];
    p.out = (float*)d_out; p.ws = (unsigned char*)d_ws;
    unsigned char* ws = (unsigned char*)d_ws;
    int nd = 0;
    auto add = [&](const float* W, const float* gain, size_t off, int K, int N, int mode, int slot = 0) { mode |= slot << 4; TrDesc& t = p.tr[nd++]; t.W = W; t.gain = gain; t.WT = (bf16_t*)(ws + off); t.K = K; t.N = N; t.ldk = K; t.mode = mode; };
    const float* mixn = p.in[3]; const float* ffnn = p.in[4]; const float* plen = p.in[5];
    for (int j = 0; j < 2; ++j) {
        const size_t wm = OFF_WMLA + (size_t)j * 20 * MiB; const int layer = 2 * j;
        add(p.in[6] + (size_t)j * DM * 1088, mixn + layer * DM, wm, DM, 1088, 2);
        add(p.in[8] + (size_t)j * 512 * NQ, p.in[7] + j * 512, wm + 5 * MiB, 512, NQ, 0);
        add(p.in[10] + (size_t)j * 512 * NKV, p.in[9] + j * 512, wm + 8 * MiB, 512, NKV, 0);
        add(p.in[13] + (size_t)j * DM * DM, nullptr, wm + 12 * MiB, DM, DM, 0, j == 0 ? 0 : 3);
        const size_t wh = OFF_WHG + (size_t)j * 40 * MiB; const int hl = 2 * j + 1;
        add(p.in[15] + (size_t)j * DM * NHG, mixn + hl * DM, wh, DM, NHG, 2, j == 0 ? 1 : 4);
        add(p.in[17] + (size_t)j * DM * DM, nullptr, wh + 32 * MiB, DM, DM, 0, j == 0 ? 2 : 5);
    }
    for (int l = 0; l < 4; ++l) {
        const size_t wl = OFF_W + (size_t)l * 75 * MiB;
        add(p.in[18] + (size_t)l * DM * 2 * DFF, ffnn + l * DM, wl, DM, 2 * DFF, 3);
        add(p.in[21] + (size_t)l * DFF * DM, nullptr, wl + 44 * MiB, DFF, DM, 0, l == 0 ? 0 : (l == 1 ? 2 : (l == 2 ? 3 : 5)));
        add(p.in[23] + (size_t)l * DM * DM, plen + l * DM, wl + 66 * MiB, DM, DM, 2);
        add(p.in[22] + (size_t)l * 256 * DM, nullptr, wl + 74 * MiB, 256, DM, 0);
    }
#if MK_ONE_LAUNCH
    if (hipMemsetAsync(ws + OFF_BAR, 0, 16384, stream) != hipSuccess) fprintf(stderr, "kernel_launch: memset failed\n");
    p.ph_lo = 0; p.ph_hi = NPHASES;
    void* args[] = {&p};
    hipError_t e = hipLaunchCooperativeKernel((const void*)trunk_fwd, dim3(grid), dim3(512), args, LDS_BYTES, stream);
    if (e != hipSuccess) fprintf(stderr, "cooperative launch failed: %s (grid %d)\n", hipGetErrorString(e), grid);
#else
    for (int ph = 0; ph < NPHASES; ++ph) {
        p.ph_lo = ph; p.ph_hi = ph + 1;
        hipLaunchKernelGGL(trunk_fwd, dim3(grid), dim3(512), LDS_BYTES, stream, p);
    }
#endif
}
```

```cpp
#include <hip/hip_runtime.h>
#include <hip/hip_cooperative_groups.h>
#include <cstdio>
#include <cstdint>
namespace cg = cooperative_groups;

#ifndef PROBE_MASK
#define PROBE_MASK 0ull
#endif
#ifndef MK_ONE_LAUNCH
#define MK_ONE_LAUNCH 1
#endif

#define LAS __attribute__((address_space(3)))
typedef unsigned short bf16_t;
typedef short bf16x8 __attribute__((ext_vector_type(8)));
typedef float f32x4 __attribute__((ext_vector_type(4)));
typedef _Float16 f16x8 __attribute__((ext_vector_type(8)));
typedef float f32x16 __attribute__((ext_vector_type(16)));
typedef unsigned u32x4 __attribute__((ext_vector_type(4)));
typedef unsigned u32x2 __attribute__((ext_vector_type(2)));

__device__ __forceinline__ unsigned cvt_pk_bf16(float lo, float hi) { unsigned r; asm volatile("v_cvt_pk_bf16_f32 %0, %1, %2" : "=v"(r) : "v"(lo), "v"(hi)); return r; }
__device__ __forceinline__ float bf_lo(unsigned w) { return __uint_as_float(w << 16); }
__device__ __forceinline__ float bf_hi(unsigned w) { return __uint_as_float(w & 0xffff0000u); }
__device__ __forceinline__ float bf1(bf16_t b) { return __uint_as_float((unsigned)b << 16); }
__device__ __forceinline__ bf16_t f2bf(float f) { return (bf16_t)(cvt_pk_bf16(f, 0.f) & 0xffffu); }
__device__ __forceinline__ unsigned pk_f16(float lo, float hi) { return (unsigned)__builtin_bit_cast(unsigned short, (_Float16)lo) | ((unsigned)__builtin_bit_cast(unsigned short, (_Float16)hi) << 16); }
__device__ __forceinline__ float f16_lo(unsigned w) { return (float)__builtin_bit_cast(_Float16, (unsigned short)(w & 0xffffu)); }
__device__ __forceinline__ float f16_hi(unsigned w) { return (float)__builtin_bit_cast(_Float16, (unsigned short)(w >> 16)); }
__device__ __forceinline__ float sigmoidf_(float x) { return __builtin_amdgcn_rcpf(1.f + __builtin_amdgcn_exp2f(x * -1.4426950408889634f)); }
__device__ __forceinline__ float dot4(f32x4 a) { return (a[0] * a[0] + a[1] * a[1]) + (a[2] * a[2] + a[3] * a[3]); }
__device__ __forceinline__ void atomic_addf(float* p, float v) { (void)__hip_atomic_fetch_add(p, v, __ATOMIC_RELAXED, __HIP_MEMORY_SCOPE_AGENT); }

__device__ __forceinline__ void load8(const bf16_t* p, float (&v)[8]) { const u32x4 w = *(const u32x4*)p; v[0] = bf_lo(w.x); v[1] = bf_hi(w.x); v[2] = bf_lo(w.y); v[3] = bf_hi(w.y); v[4] = bf_lo(w.z); v[5] = bf_hi(w.z); v[6] = bf_lo(w.w); v[7] = bf_hi(w.w); }
__device__ __forceinline__ void unpack8(const u32x4 w, float (&v)[8]) { v[0] = bf_lo(w.x); v[1] = bf_hi(w.x); v[2] = bf_lo(w.y); v[3] = bf_hi(w.y); v[4] = bf_lo(w.z); v[5] = bf_hi(w.z); v[6] = bf_lo(w.w); v[7] = bf_hi(w.w); }
__device__ __forceinline__ void store8(bf16_t* p, const float (&v)[8]) { u32x4 w; w.x = cvt_pk_bf16(v[0], v[1]); w.y = cvt_pk_bf16(v[2], v[3]); w.z = cvt_pk_bf16(v[4], v[5]); w.w = cvt_pk_bf16(v[6], v[7]); *(u32x4*)p = w; }
__device__ __forceinline__ u32x4 pack_f16x8_(const f32x4 a, const f32x4 b) { u32x4 w; w.x = pk_f16(a[0], a[1]); w.y = pk_f16(a[2], a[3]); w.z = pk_f16(b[0], b[1]); w.w = pk_f16(b[2], b[3]); return w; }
constexpr int M = 8192, DM = 2048, SEQ = 2048, NB = 4, NH = 16;
constexpr int DFF = 5632, CA = 1280, NQ = 3072, NKV = 4096, NHG = 8192;
constexpr float EPS = 1e-6f;

namespace pg8 {
constexpr int BM = 256, BK = 64, HALF = 128, HTB = HALF * BK * 2, STAGE_BYTES = 8 * HTB, NXCD = 8, WGM = 8;
__host__ __device__ __forceinline__ int lds_byte(int r, int c) { const int st = (r >> 4) * 2 + (c >> 5), rr = r & 15, cc = c & 31, ob = rr * 64 + cc * 2; return st * 1024 + (ob ^ (((ob >> 9) & 1) << 5)); }
__host__ __device__ __forceinline__ void stage_rc(int b, int& R, int& C) { const int st = b / 1024, sb = b % 1024, swz = sb ^ (((sb >> 9) & 1) << 5); R = (st >> 1) * 16 + swz / 64; C = (st & 1) * 32 + (swz % 64) / 2; }
__host__ __device__ __forceinline__ int perm32(int rho) { const int n = rho >> 4, i = rho & 15; return 8 * (i >> 2) + 4 * n + (i & 3); }

struct Unit { int pm, pn; };
struct Gemm { const bf16_t* A; const bf16_t* Bt; int M, N, K, lda, ldb; };

struct StaticOrder {
    int nM, nN, nwg, G, c;
    __device__ void init(int M_, int N_, int G_, int c_) { nM = M_ / BM; nN = N_ / BM; nwg = nM * nN; G = G_; c = c_; }
    __device__ bool next(int i, Unit& u) const {
        const long L = (long)i * G + c; if (L >= nwg) return false;
        int wgid = (int)L; { const int q = nwg / NXCD, r = nwg % NXCD, xcd = wgid % NXCD, off = wgid / NXCD; wgid = (xcd < r ? xcd * (q + 1) : r * (q + 1) + (xcd - r) * q) + off; }
        const int nig = WGM * nN, gid = wgid / nig, fm = gid * WGM, gsz = (nM - fm) < WGM ? (nM - fm) : WGM;
        u.pm = fm + ((wgid % nig) % gsz); u.pn = (wgid % nig) / gsz; return true;
    }
};

typedef f32x4 Acc[2][2][4][2];
constexpr int LDS_RSTD = 131072 + 1024;
template <class Epi> __device__ __forceinline__ void rstd_issue(const Epi& E, int pm, int tid, f32x4 (&pf)[4]) {
    const f32x4* p = (const f32x4*)(E.ssq_in + (size_t)(pm * BM + (tid >> 1)) * 32); const int half = tid & 1;
    if (E.np4v() == 8) {
#pragma unroll
        for (int k = 0; k < 4; ++k) pf[k] = p[4 * half + k];
    } else { pf[0] = p[half]; pf[1] = (f32x4){0.f, 0.f, 0.f, 0.f}; pf[2] = pf[1]; pf[3] = pf[1]; }
}
template <class Epi> __device__ __forceinline__ void rstd_store(const Epi& E, const f32x4 (&pf)[4], LAS float* tab, int tid) {
    float s = 0.f;
#pragma unroll
    for (int k = 0; k < 4; ++k) s += (pf[k][0] + pf[k][1]) + (pf[k][2] + pf[k][3]);
    s += __shfl_xor(s, 1);
    if ((tid & 1) == 0) tab[tid >> 1] = rsqrtf(s * E.invn + 1e-6f);
}

template <class Epi>
__device__ __forceinline__ void gemm_phase(LAS unsigned char* lds, const Gemm g, const StaticOrder& S, const Epi& E, int tid_in) {
    const int tid = tid_in, wid = __builtin_amdgcn_readfirstlane(tid >> 6), lane = tid & 63, wr = wid >> 2, wc = wid & 3, fr = lane & 15, fq = lane >> 4;
    const int K = g.K, nt = K / BK;
    unsigned voffA[2], voffB[2];
#pragma unroll
    for (int i = 0; i < 2; ++i) { int R, C; stage_rc(tid * 16 + i * 8192, R, C); const int Rb = Epi::PERM ? ((R & ~31) + perm32(R & 31)) : R;
        voffA[i] = (unsigned)(R * g.lda + C) * 2u; voffB[i] = (unsigned)(Rb * g.ldb + C) * 2u; }
    const size_t kstep = (size_t)(BK * 2);
    const size_t hA = (size_t)HALF * g.lda * 2, hB = (size_t)HALF * g.ldb * 2;
    const size_t tA = 2 * hA, tB = 2 * hB;
    const unsigned ldsw = (unsigned)wid * 1024u;
    const int aoff = lds_byte(wr * 64 + fr, fq * 8), boff = lds_byte(wc * 32 + fr, fq * 8);
#define PG8_SA(b, h) (((b) * 2 + (h)) * HTB)
#define PG8_SB(b, h) ((4 + (b) * 2 + (h)) * HTB)
#define PG8_STAGE(bufoff, gbase, voff) do { _Pragma("unroll") for (int _i = 0; _i < 2; ++_i) \
        __builtin_amdgcn_global_load_lds((const unsigned*)((const char*)(gbase) + (voff)[_i]), (LAS unsigned*)(lds + (bufoff) + ldsw + _i * 8192), 16, 0, 0); } while (0)
#define PG8_LDA(dst, b, h) do { _Pragma("unroll") for (int m = 0; m < 4; ++m) _Pragma("unroll") for (int k = 0; k < 2; ++k) dst[m][k] = *(const LAS bf16x8*)(lds + PG8_SA(b, h) + aoff + m * 2048 + k * 1024); } while (0)
#define PG8_LDB(dst, b, h) do { _Pragma("unroll") for (int n = 0; n < 2; ++n) _Pragma("unroll") for (int k = 0; k < 2; ++k) dst[n][k] = *(const LAS bf16x8*)(lds + PG8_SB(b, h) + boff + n * 2048 + k * 1024); } while (0)
#define PG8_MMA(ai, bj, At, Bt) do { __builtin_amdgcn_s_setprio(1); _Pragma("unroll") for (int m = 0; m < 4; ++m) _Pragma("unroll") for (int n = 0; n < 2; ++n) _Pragma("unroll") for (int k = 0; k < 2; ++k) \
        { if constexpr (Epi::F16) acc[ai][bj][m][n] = __builtin_amdgcn_mfma_f32_16x16x32_f16(__builtin_bit_cast(f16x8, Bt[n][k]), __builtin_bit_cast(f16x8, At[m][k]), acc[ai][bj][m][n], 0, 0, 0); \
          else acc[ai][bj][m][n] = __builtin_amdgcn_mfma_f32_16x16x32_bf16(Bt[n][k], At[m][k], acc[ai][bj][m][n], 0, 0, 0); } __builtin_amdgcn_s_setprio(0); } while (0)
#define PG8_WAIT_V(n) asm volatile("s_waitcnt vmcnt(" #n ")" ::: "memory")
#define PG8_WAIT_L(n) asm volatile("s_waitcnt lgkmcnt(" #n ")" ::: "memory")
#define PG8_BAR __builtin_amdgcn_s_barrier()
#define PG8_SCHED __builtin_amdgcn_sched_barrier(0)
    Unit cur, nxt; int ui = 0;
    if (!S.next(0, cur)) return;
    Acc acc;
#pragma unroll
    for (int a = 0; a < 2; ++a)
#pragma unroll
        for (int b = 0; b < 2; ++b)
#pragma unroll
            for (int m = 0; m < 4; ++m)
#pragma unroll
                for (int n = 0; n < 2; ++n) acc[a][b][m][n] = (f32x4){0.f, 0.f, 0.f, 0.f};
    bf16x8 At[4][2], B0[2][2], B1[2][2];
    LAS float* rtab = (LAS float*)(lds + LDS_RSTD);
    f32x4 pf0[4]; if constexpr (Epi::RSTD) rstd_issue(E, cur.pm, tid, pf0);
    const char* cA = (const char*)g.A + (size_t)cur.pm * tA; const char* cB = (const char*)g.Bt + (size_t)cur.pn * tB;
    PG8_STAGE(PG8_SB(0, 0), cB, voffB); PG8_STAGE(PG8_SB(0, 1), cB + hB, voffB); PG8_STAGE(PG8_SA(0, 0), cA, voffA); PG8_STAGE(PG8_SA(0, 1), cA + hA, voffA);
    if (wr == 1) PG8_BAR;
    PG8_WAIT_V(2); PG8_BAR;
    if constexpr (Epi::RSTD) rstd_store(E, pf0, rtab, tid);
    PG8_STAGE(PG8_SB(1, 0), cB + kstep, voffB); PG8_STAGE(PG8_SA(1, 0), cA + kstep, voffA); PG8_STAGE(PG8_SB(1, 1), cB + hB + kstep, voffB);
    PG8_WAIT_V(6); PG8_BAR;
    for (;;) {
        const bool has_next = S.next(ui + 1, nxt);
        const char* nA = has_next ? (const char*)g.A + (size_t)nxt.pm * tA : cA; const char* nB = has_next ? (const char*)g.Bt + (size_t)nxt.pn * tB : cB;
        for (int t = 0; t < nt; t += 2) {
            const bool last = (t == nt - 2);
            const char* a1 = cA + (size_t)(t + 1) * kstep;
            const char* a2 = last ? nA : cA + (size_t)(t + 2) * kstep; const char* b2 = last ? nB : cB + (size_t)(t + 2) * kstep;
            const char* a3 = a2 + kstep; const char* b3 = b2 + kstep;
            PG8_LDB(B0, 0, 0); PG8_LDB(B1, 0, 1); PG8_SCHED; PG8_LDA(At, 0, 0); PG8_STAGE(PG8_SA(1, 1), a1 + hA, voffA);
            PG8_WAIT_V(8); PG8_WAIT_L(0); PG8_BAR; PG8_MMA(0, 0, At, B0); PG8_MMA(0, 1, At, B1); PG8_BAR; PG8_SCHED;
            PG8_LDA(At, 0, 1); PG8_STAGE(PG8_SB(0, 0), b2, voffB); PG8_STAGE(PG8_SB(0, 1), b2 + hB, voffB); PG8_STAGE(PG8_SA(0, 0), a2, voffA);
            PG8_WAIT_V(8); PG8_WAIT_L(0); PG8_BAR; PG8_MMA(1, 0, At, B0); PG8_MMA(1, 1, At, B1); PG8_BAR; PG8_SCHED;
            PG8_LDB(B0, 1, 0); PG8_LDB(B1, 1, 1); PG8_SCHED; PG8_LDA(At, 1, 0); PG8_STAGE(PG8_SA(0, 1), a2 + hA, voffA);
            PG8_WAIT_V(8); PG8_WAIT_L(0); PG8_BAR; PG8_MMA(0, 0, At, B0); PG8_MMA(0, 1, At, B1); PG8_BAR; PG8_SCHED;
            PG8_LDA(At, 1, 1); PG8_STAGE(PG8_SB(1, 0), b3, voffB); PG8_STAGE(PG8_SB(1, 1), b3 + hB, voffB); PG8_STAGE(PG8_SA(1, 0), a3, voffA);
            PG8_WAIT_V(8); PG8_WAIT_L(0); PG8_BAR; PG8_MMA(1, 0, At, B0); PG8_MMA(1, 1, At, B1); PG8_BAR; PG8_SCHED;
        }
        if (wr == 0) PG8_BAR;
        E(acc, cur, wr, wc, fr, fq, rtab + (ui & 1) * 256, has_next ? nxt.pm : -1, rtab + ((ui + 1) & 1) * 256, tid);
        if (!has_next) break;
#pragma unroll
        for (int a = 0; a < 2; ++a)
#pragma unroll
            for (int b = 0; b < 2; ++b)
#pragma unroll
                for (int m = 0; m < 4; ++m)
#pragma unroll
                    for (int n = 0; n < 2; ++n) acc[a][b][m][n] = (f32x4){0.f, 0.f, 0.f, 0.f};
        cur = nxt; cA = nA; cB = nB; ++ui;
        if (wr == 1) PG8_BAR;
    }
    PG8_WAIT_V(0);
    PG8_BAR;
#undef PG8_SA
#undef PG8_SB
#undef PG8_STAGE
#undef PG8_LDA
#undef PG8_LDB
#undef PG8_MMA
#undef PG8_WAIT_V
#undef PG8_WAIT_L
#undef PG8_BAR
#undef PG8_SCHED
}

__device__ __forceinline__ float row_rstd(const float* ssq, int r, float invn, int np4, int fq) {
    if (!ssq) return 1.f;
    const f32x4* p = (const f32x4*)(ssq + (size_t)r * 32); float s = 0.f;
    if (np4 == 8) { const f32x4 a = p[2 * fq], c = p[2 * fq + 1]; s = ((a[0] + a[1]) + (a[2] + a[3])) + ((c[0] + c[1]) + (c[2] + c[3])); }
    else if (fq < 2) { const f32x4 a = p[fq]; s = (a[0] + a[1]) + (a[2] + a[3]); }
    s += __shfl_xor(s, 16); s += __shfl_xor(s, 32);
    return rsqrtf(s * invn + EPS);
}
__device__ __forceinline__ void row_rstd4(const float* ssq, int rowh, float invn, int np4, int fq, float (&rs)[4]) {
    if (!ssq) {
#pragma unroll
        for (int m = 0; m < 4; ++m) rs[m] = 1.f;
        return; }
    float sp[4];
#pragma unroll
    for (int m = 0; m < 4; ++m) { const f32x4* p = (const f32x4*)(ssq + (size_t)(rowh + m * 16) * 32); float s = 0.f;
        if (np4 == 8) { const f32x4 a = p[2 * fq], c = p[2 * fq + 1]; s = ((a[0] + a[1]) + (a[2] + a[3])) + ((c[0] + c[1]) + (c[2] + c[3])); }
        else if (fq < 2) { const f32x4 a = p[fq]; s = (a[0] + a[1]) + (a[2] + a[3]); }
        sp[m] = s; }
#pragma unroll
    for (int m = 0; m < 4; ++m) { float s = sp[m]; s += __shfl_xor(s, 16); s += __shfl_xor(s, 32); rs[m] = rsqrtf(s * invn + EPS); }
}
__device__ __forceinline__ u32x4 pack8(f32x4 a, f32x4 b) { u32x4 w; w.x = cvt_pk_bf16(a[0], a[1]); w.y = cvt_pk_bf16(a[2], a[3]); w.z = cvt_pk_bf16(b[0], b[1]); w.w = cvt_pk_bf16(b[2], b[3]); return w; }

template <bool F16_> struct EpiBf16S {
    static constexpr bool PERM = true, RSTD = true, F16 = F16_;
    __device__ __forceinline__ int np4v() const { return np4; }
    bf16_t* O; int ldc; const float* ssq_in; float invn; int np4; float* ssq0; float* ssq1;
    __device__ __forceinline__ void operator()(const Acc& acc, const Unit& u, int wr, int wc, int fr, int fq, const LAS float* tab, int nxt_pm, LAS float* ntab, int tid) const {
        const int row0 = u.pm * BM + wr * 64 + fr, col0 = u.pn * BM + wc * 32 + 8 * fq;
        float* sq = ssq0 ? (u.pn < 2 ? ssq0 : (u.pn < 4 ? ssq1 : nullptr)) : nullptr;
        f32x4 pf[4]; if (nxt_pm >= 0) rstd_issue(*this, nxt_pm, tid, pf);
#pragma unroll
        for (int ai = 0; ai < 2; ++ai) {
#pragma unroll
            for (int m = 0; m < 4; ++m) { const int r = row0 + ai * HALF + m * 16; const float rs = tab[ai * HALF + wr * 64 + m * 16 + fr]; float part = 0.f;
#pragma unroll
                for (int bj = 0; bj < 2; ++bj) { const f32x4 v0 = acc[ai][bj][m][0] * rs, v1 = acc[ai][bj][m][1] * rs; part += dot4(v0) + dot4(v1);
                    *(u32x4*)(O + (size_t)r * ldc + col0 + bj * HALF) = pack8(v0, v1); }
                if (sq) { part += __shfl_xor(part, 16); part += __shfl_xor(part, 32); if (fq == 0) sq[(size_t)r * 32 + (u.pn & 1) * 4 + wc] = part; } } }
        if (nxt_pm >= 0) rstd_store(*this, pf, ntab, tid);
    }
};
__device__ __forceinline__ float dpp_ror1(float x) { return __builtin_bit_cast(float, __builtin_amdgcn_update_dpp(0, __builtin_bit_cast(int, x), 0x121, 0xf, 0xf, false)); }
__device__ __forceinline__ float dpp_ror2(float x) { return __builtin_bit_cast(float, __builtin_amdgcn_update_dpp(0, __builtin_bit_cast(int, x), 0x122, 0xf, 0xf, false)); }
struct EpiFfnIn {
    static constexpr bool PERM = true, RSTD = true, F16 = true;
    __device__ __forceinline__ int np4v() const { return 8; }
    bf16_t* Gt; bf16_t* Up; bf16_t* Act; const float* ssq_in; float invn; const float* cw; const float* cb;
    __device__ __forceinline__ void operator()(const Acc& acc, const Unit& u, int wr, int wc, int fr, int fq, const LAS float* tab, int nxt_pm, LAS float* ntab, int tid) const {
        const int row0 = u.pm * BM + wr * 64 + fr, col0 = u.pn * HALF + wc * 32 + 8 * fq;
        float w0[8], w1[8], w2[8], bb[8];
#pragma unroll
        for (int h = 0; h < 2; ++h) { const f32x4 a = *(const f32x4*)(cw + col0 + 4 * h), b = *(const f32x4*)(cw + DFF + col0 + 4 * h), c = *(const f32x4*)(cw + 2 * DFF + col0 + 4 * h), d = *(const f32x4*)(cb + col0 + 4 * h);
#pragma unroll
            for (int j = 0; j < 4; ++j) { w0[4 * h + j] = a[j]; w1[4 * h + j] = b[j]; w2[4 * h + j] = c[j]; bb[4 * h + j] = d[j]; } }
        f32x4 pf[4]; if (nxt_pm >= 0) rstd_issue(*this, nxt_pm, tid, pf);
#pragma unroll
        for (int ai = 0; ai < 2; ++ai) {
            float p1[8] = {0.f, 0.f, 0.f, 0.f, 0.f, 0.f, 0.f, 0.f}, p2[8] = {0.f, 0.f, 0.f, 0.f, 0.f, 0.f, 0.f, 0.f};
#pragma unroll
            for (int m = 0; m < 4; ++m) { const int r = row0 + ai * HALF + m * 16; const float rs = tab[ai * HALF + wr * 64 + m * 16 + fr];
                float g[8], up[8], r1[8], r2[8], o[8];
#pragma unroll
                for (int j = 0; j < 4; ++j) { g[j] = acc[ai][0][m][0][j] * rs; g[4 + j] = acc[ai][0][m][1][j] * rs; up[j] = acc[ai][1][m][0][j] * rs; up[4 + j] = acc[ai][1][m][1][j] * rs; }
#pragma unroll
                for (int j = 0; j < 8; ++j) { r1[j] = dpp_ror1(g[j]); r2[j] = dpp_ror2(g[j]); }
                const size_t off = (size_t)r * DFF + col0;
                if (m == 0 && fr < 2) { store8(Gt + off, g); store8(Up + off, up); }
                else {
#pragma unroll
                    for (int j = 0; j < 8; ++j) { const float a1 = (fr >= 1) ? r1[j] : p1[j], a2 = (fr >= 2) ? r2[j] : p2[j]; const float cv = bb[j] + w0[j] * a2 + w1[j] * a1 + w2[j] * g[j]; o[j] = cv * sigmoidf_(cv) * up[j]; }
                    store8(Act + off, o);
                    if (m == 3 && fr >= 14) store8(Gt + off, g);
                }
#pragma unroll
                for (int j = 0; j < 8; ++j) { p1[j] = r1[j]; p2[j] = r2[j]; }
            }
        }
        if (nxt_pm >= 0) rstd_store(*this, pf, ntab, tid);
    }
};
struct EpiHgrnIn {
    static constexpr bool PERM = true, RSTD = true, F16 = true;
    __device__ __forceinline__ int np4v() const { return 8; }
    bf16_t* QS; bf16_t* LOGF; bf16_t* KK; bf16_t* V; bf16_t* GS; const float* lb; const float* ssq_in; float invn;
    __device__ __forceinline__ void operator()(const Acc& acc, const Unit& u, int wr, int wc, int fr, int fq, const LAS float* tab, int nxt_pm, LAS float* ntab, int tid) const {
        const int part = u.pn >> 3;
        const int row0 = u.pm * BM + wr * 64 + fr, col0 = (u.pn & 7) * BM + wc * 32 + 8 * fq;
        f32x4 l0[2], l1[2];
        if (part == 1) {
#pragma unroll
            for (int bj = 0; bj < 2; ++bj) { l0[bj] = *(const f32x4*)(lb + col0 + bj * HALF); l1[bj] = *(const f32x4*)(lb + col0 + bj * HALF + 4); }
        }
        f32x4 pf[4]; if (nxt_pm >= 0) rstd_issue(*this, nxt_pm, tid, pf);
#pragma unroll
        for (int ai = 0; ai < 2; ++ai) {
#pragma unroll
            for (int m = 0; m < 4; ++m) { const int r = row0 + ai * HALF + m * 16; const float rs = tab[ai * HALF + wr * 64 + m * 16 + fr];
#pragma unroll
                for (int bj = 0; bj < 2; ++bj) { f32x4 v0 = acc[ai][bj][m][0] * rs, v1 = acc[ai][bj][m][1] * rs; const size_t o = (size_t)r * DM + col0 + bj * HALF;
                    if (part == 0 || part == 3) {
#pragma unroll
                        for (int j = 0; j < 4; ++j) { v0[j] = v0[j] * sigmoidf_(v0[j]); v1[j] = v1[j] * sigmoidf_(v1[j]); }
                        *(u32x4*)((part == 0 ? QS : GS) + o) = pack8(v0, v1);
                    } else if (part == 2) {
                        *(u32x4*)(V + o) = pack8(v0, v1);
                    } else {
                        f32x4 lf0, lf1;
#pragma unroll
                        for (int j = 0; j < 4; ++j) { const float s0 = sigmoidf_(v0[j]), s1 = sigmoidf_(v1[j]); const float a0 = l0[bj][j], a1 = l1[bj][j];
                            lf0[j] = __logf(a0 + (1.f - a0) * s0); lf1[j] = __logf(a1 + (1.f - a1) * s1); }
                        *(u32x4*)(LOGF + o) = pack_f16x8_(lf0, lf1);
                    } } } }
        if (nxt_pm >= 0) rstd_store(*this, pf, ntab, tid);
    }
};
__device__ __forceinline__ void unpack_f16x8(const u32x4 w, f32x4& a, f32x4& b) { a = (f32x4){f16_lo(w.x), f16_hi(w.x), f16_lo(w.y), f16_hi(w.y)}; b = (f32x4){f16_lo(w.z), f16_hi(w.z), f16_lo(w.w), f16_hi(w.w)}; }
__device__ __forceinline__ u32x4 pack_f16x8(const f32x4 a, const f32x4 b) { u32x4 w; w.x = pk_f16(a[0], a[1]); w.y = pk_f16(a[2], a[3]); w.z = pk_f16(b[0], b[1]); w.w = pk_f16(b[2], b[3]); return w; }
struct EpiRes {
    static constexpr bool PERM = true, RSTD = false, F16 = false;
    const float* base32; const bf16_t* base16; bf16_t* hb; bf16_t* hf; float* ssq_out; float* out32;
    __device__ __forceinline__ void operator()(const Acc& acc, const Unit& u, int wr, int wc, int fr, int fq, const LAS float* tab, int nxt_pm, LAS float* ntab, int tid) const {
        const int row0 = u.pm * BM + wr * 64 + fr, col0 = u.pn * BM + wc * 32 + 8 * fq;
#pragma unroll
        for (int am = 0; am < 4; ++am) { const int ai = am >> 1, mb = (am & 1) * 2;
            f32x4 b0[4][2], b1[4][2];
            if (base32) {
#pragma unroll
                for (int m = mb; m < mb + 2; ++m)
#pragma unroll
                    for (int bj = 0; bj < 2; ++bj) { const float* p = base32 + (size_t)(row0 + ai * HALF + m * 16) * DM + col0 + bj * HALF; b0[m][bj] = *(const f32x4*)p; b1[m][bj] = *(const f32x4*)(p + 4); }
            } else {
                u32x4 bw[4][2];
#pragma unroll
                for (int m = mb; m < mb + 2; ++m)
#pragma unroll
                    for (int bj = 0; bj < 2; ++bj) bw[m][bj] = *(const u32x4*)(base16 + (size_t)(row0 + ai * HALF + m * 16) * DM + col0 + bj * HALF);
#pragma unroll
                for (int m = mb; m < mb + 2; ++m)
#pragma unroll
                    for (int bj = 0; bj < 2; ++bj) unpack_f16x8(bw[m][bj], b0[m][bj], b1[m][bj]);
            }
#pragma unroll
            for (int m = mb; m < mb + 2; ++m) { const int r = row0 + ai * HALF + m * 16; float part = 0.f;
#pragma unroll
                for (int bj = 0; bj < 2; ++bj) { const size_t o = (size_t)r * DM + col0 + bj * HALF;
                    const f32x4 v0 = b0[m][bj] + acc[ai][bj][m][0], v1 = b1[m][bj] + acc[ai][bj][m][1]; part += dot4(v0) + dot4(v1);
                    *(u32x4*)(hf + o) = pack_f16x8(v0, v1);
                    if (out32) { *(f32x4*)(out32 + o) = v0; *(f32x4*)(out32 + o + 4) = v1; } }
                part += __shfl_xor(part, 16); part += __shfl_xor(part, 32); if (fq == 0) ssq_out[(size_t)r * 32 + u.pn * 4 + wc] = part; }
        }
    }
};
struct EpiProj {
    static constexpr bool PERM = true, RSTD = false, F16 = false;
    bf16_t* P;
    __device__ __forceinline__ void operator()(const Acc& acc, const Unit& u, int wr, int wc, int fr, int fq, const LAS float* tab, int nxt_pm, LAS float* ntab, int tid) const {
        const int row0 = u.pm * BM + wr * 64 + fr, col0 = u.pn * BM + wc * 32 + 8 * fq;
#pragma unroll
        for (int ai = 0; ai < 2; ++ai)
#pragma unroll
            for (int m = 0; m < 4; ++m) { const int r = row0 + ai * HALF + m * 16;
#pragma unroll
                for (int bj = 0; bj < 2; ++bj) *(u32x4*)(P + (size_t)r * DM + col0 + bj * HALF) = pack8(acc[ai][bj][m][0], acc[ai][bj][m][1]); }
    }
};
struct EpiPle {
    static constexpr bool PERM = true, RSTD = true, F16 = true;
    __device__ __forceinline__ int np4v() const { return 8; }
    const bf16_t* base16; bf16_t* hb; bf16_t* hf; float* ssq_out; const bf16_t* P; const float* ssq_in; float invn; float* out32;
    __device__ __forceinline__ void operator()(const Acc& acc, const Unit& u, int wr, int wc, int fr, int fq, const LAS float* tab, int nxt_pm, LAS float* ntab, int tid) const {
        const int row0 = u.pm * BM + wr * 64 + fr, col0 = u.pn * BM + wc * 32 + 8 * fq;
#pragma unroll
        for (int am = 0; am < 4; ++am) { const int ai = am >> 1, mb = (am & 1) * 2;
            u32x4 bw[4][2], pv[4][2];
#pragma unroll
            for (int m = mb; m < mb + 2; ++m)
#pragma unroll
                for (int bj = 0; bj < 2; ++bj) { const size_t o = (size_t)(row0 + ai * HALF + m * 16) * DM + col0 + bj * HALF; bw[m][bj] = *(const u32x4*)(base16 + o); pv[m][bj] = *(const u32x4*)(P + o); }
#pragma unroll
            for (int m = mb; m < mb + 2; ++m) { const int r = row0 + ai * HALF + m * 16; const float rs = tab[ai * HALF + wr * 64 + m * 16 + fr]; float part = 0.f;
#pragma unroll
                for (int bj = 0; bj < 2; ++bj) { const size_t o = (size_t)r * DM + col0 + bj * HALF;
                    f32x4 h0, h1; unpack_f16x8(bw[m][bj], h0, h1); const u32x4 pw = pv[m][bj]; const f32x4 a0 = acc[ai][bj][m][0] * rs, a1 = acc[ai][bj][m][1] * rs; f32x4 v0, v1;
                    v0[0] = h0[0] + bf_lo(pw.x) * sigmoidf_(a0[0]); v0[1] = h0[1] + bf_hi(pw.x) * sigmoidf_(a0[1]); v0[2] = h0[2] + bf_lo(pw.y) * sigmoidf_(a0[2]); v0[3] = h0[3] + bf_hi(pw.y) * sigmoidf_(a0[3]);
                    v1[0] = h1[0] + bf_lo(pw.z) * sigmoidf_(a1[0]); v1[1] = h1[1] + bf_hi(pw.z) * sigmoidf_(a1[1]); v1[2] = h1[2] + bf_lo(pw.w) * sigmoidf_(a1[2]); v1[3] = h1[3] + bf_hi(pw.w) * sigmoidf_(a1[3]);
                    part += dot4(v0) + dot4(v1);
                    if (out32) { *(f32x4*)(out32 + o) = v0; *(f32x4*)(out32 + o + 4) = v1; }
                    else *(u32x4*)(hf + o) = pack_f16x8(v0, v1); }
                part += __shfl_xor(part, 16); part += __shfl_xor(part, 32); if (fq == 0) ssq_out[(size_t)r * 32 + u.pn * 4 + wc] = part; }
        }
    }
};
}

constexpr size_t MiB = 1u << 20;
constexpr size_t OFF_SSQ = 956 * MiB;
constexpr size_t OFF_LB = 1 * MiB;
constexpr size_t OFF_ROPE = 2 * MiB;
constexpr size_t OFF_G = 4 * MiB;
constexpr size_t OFF_W = 8 * MiB;
constexpr size_t OFF_WMLA = OFF_W + 300 * MiB;
constexpr size_t OFF_WHG = OFF_W + 340 * MiB;
constexpr size_t OFF_HB0 = 428 * MiB, OFF_HB1 = 460 * MiB;
constexpr size_t OFF_PB = 492 * MiB;
constexpr size_t OFF_PROJ = 508 * MiB;
constexpr size_t OFF_SCR = 540 * MiB;
constexpr size_t OFF_HF0 = 976 * MiB, OFF_HF1 = 1008 * MiB;
constexpr size_t WS_NEED = 1040 * MiB;
constexpr size_t S_C = OFF_SCR, S_QRAW = OFF_SCR + 20 * MiB, S_KVRAW = OFF_SCR + 68 * MiB, S_Q = OFF_SCR + 132 * MiB, S_K = OFF_SCR + 180 * MiB, S_VT = OFF_SCR + 228 * MiB, S_O = OFF_SCR + 260 * MiB;
constexpr size_t S_QS = OFF_SCR, S_LOGF = OFF_SCR + 32 * MiB, S_KK = OFF_SCR + 96 * MiB, S_V = OFF_SCR + 128 * MiB, S_GS = OFF_SCR + 160 * MiB, S_UT = OFF_SCR + 192 * MiB, S_SP = OFF_SCR + 320 * MiB, S_OG = OFF_SCR + 384 * MiB;
constexpr size_t S_GATE = OFF_SCR, S_UP = OFF_SCR + 88 * MiB, S_ACT = OFF_SCR + 176 * MiB;

constexpr int LDS_BYTES = 147456;

struct TrDesc { const float* W; const float* gain; bf16_t* WT; int K, N, ldk, mode; };
struct Params {
    const float* in[24];
    float* out; unsigned char* ws;
    TrDesc tr[28];
    int ph_lo, ph_hi;
};
typedef const __attribute__((address_space(4))) Params* PP;

__device__ __forceinline__ float wave_sum(float v) {
#pragma unroll
    for (int o = 1; o < 64; o <<= 1) v += __shfl_xor(v, o);
    return v;
}

__device__ __forceinline__ void tr_item(const float* W, int N, const float* gain, bf16_t* WT, int ldk, int k0, int n0, int drow0, LAS unsigned* scr, int lane, bool f16) {
    const int kr = lane >> 4, n4 = (lane & 15) * 4;
    f32x4 v[16];
#pragma unroll
    for (int i = 0; i < 8; ++i) { const float* src = W + (size_t)(k0 + 8 * i + 2 * kr) * N + n0 + n4; v[2 * i] = *(const f32x4*)src; v[2 * i + 1] = *(const f32x4*)(src + N); }
#pragma unroll
    for (int i = 0; i < 8; ++i) { const int k = 8 * i + 2 * kr; float g0 = 1.f, g1 = 1.f; if (gain) { g0 = gain[k0 + k]; g1 = gain[k0 + k + 1]; }
#pragma unroll
        for (int j = 0; j < 4; ++j) scr[(n4 + j) * 33 + (k >> 1)] = f16 ? pk_f16(v[2 * i][j] * g0, v[2 * i + 1][j] * g1) : cvt_pk_bf16(v[2 * i][j] * g0, v[2 * i + 1][j] * g1); }
    asm volatile("s_waitcnt lgkmcnt(0)" ::: "memory");
#pragma unroll
    for (int qd = 0; qd < 8; ++qd) { const int c = lane + 64 * qd, n = c >> 3, kc = (c & 7) * 4; const LAS unsigned* sp = scr + n * 33 + kc;
        u32x4 o; o.x = sp[0]; o.y = sp[1]; o.z = sp[2]; o.w = sp[3];
        *(u32x4*)(WT + (size_t)(drow0 + n) * ldk + k0 + 2 * kc) = o; }
    asm volatile("s_waitcnt lgkmcnt(0)" ::: "memory");
}

__device__ __forceinline__ void convert_descs(PP pp, LAS unsigned char* lds, int slot, int gw, int NGW, int wave, int lane) {
    LAS unsigned* scr = (LAS unsigned*)(lds + wave * 16384);
    for (int d = 0; d < 28; ++d) {
        const int mode = pp->tr[d].mode; if ((mode >> 4) != slot) continue;
        const float* W = pp->tr[d].W; const float* gain = pp->tr[d].gain; bf16_t* WT = pp->tr[d].WT; const int K = pp->tr[d].K, N = pp->tr[d].N, ldk = pp->tr[d].ldk;
        const int nblk = N / 64, nitems = (K / 64) * nblk;
        for (int it = gw; it < nitems; it += NGW) {
            const int kb = it / nblk, nb = it % nblk, n0 = nb * 64; int drow0 = n0;
            if (mode & 1) { const int up = n0 >= DFF ? 1 : 0, cc = n0 - up * DFF; drow0 = (cc >> 7) * 256 + up * 128 + (cc & 127); }
            tr_item(W, N, gain, WT, ldk, kb * 64, n0, drow0, scr, lane, (mode & 2) != 0);
        }
    }
}
__device__ __forceinline__ void prologue(PP pp, LAS unsigned char* lds, int G, int bid, int tid_in) {
    const int tid = tid_in, lane = tid & 63, wave = __builtin_amdgcn_readfirstlane(tid >> 6);
    const int gw = bid * 8 + wave, NGW = G * 8;
    const int gt = bid * 512 + tid, NGT = G * 512;
    unsigned char* ws = pp->ws;
    convert_descs(pp, lds, 0, gw, NGW, wave, lane);
    for (int j = 0; j < 2; ++j) { u32x4* z = (u32x4*)(ws + OFF_WMLA + j * 20 * MiB + (size_t)1088 * DM * 2); const int n16 = 192 * DM * 2 / 16;
        for (int i = gt; i < n16; i += NGT) z[i] = (u32x4){0u, 0u, 0u, 0u}; }
    { const float* x = pp->in[0]; bf16_t* hb = (bf16_t*)(ws + OFF_HF0); float* ssq = (float*)(ws + OFF_SSQ);
      for (int r = gw; r < M; r += 2 * NGW) { const int r1 = (r + NGW < M) ? r + NGW : r;
          const f32x4* xa = (const f32x4*)(x + (size_t)r * DM) + lane; const f32x4* xb = (const f32x4*)(x + (size_t)r1 * DM) + lane; f32x4 va[8], vb[8];
#pragma unroll
          for (int j = 0; j < 8; ++j) { va[j] = xa[64 * j]; vb[j] = xb[64 * j]; }
          u32x2* oa = (u32x2*)(hb + (size_t)r * DM) + lane; u32x2* ob = (u32x2*)(hb + (size_t)r1 * DM) + lane; float sa = 0.f, sb = 0.f;
#pragma unroll
          for (int j = 0; j < 8; ++j) { sa += dot4(va[j]); sb += dot4(vb[j]); u32x2 w; w.x = pk_f16(va[j][0], va[j][1]); w.y = pk_f16(va[j][2], va[j][3]); oa[64 * j] = w;
              u32x2 w2; w2.x = pk_f16(vb[j][0], vb[j][1]); w2.y = pk_f16(vb[j][2], vb[j][3]); ob[64 * j] = w2; }
          sa = wave_sum(sa); sb = wave_sum(sb);
          if (lane < 32) { ssq[(size_t)r * 32 + lane] = lane == 0 ? sa : 0.f; ssq[(size_t)r1 * 32 + lane] = lane == 0 ? sb : 0.f; } } }
    { const f32x4* src = (const f32x4*)pp->in[1]; u32x2* dst = (u32x2*)(ws + OFF_PB); const int n4 = 4 * M * 256 / 4;
      for (int i0 = gt; i0 < n4; i0 += 8 * NGT) { f32x4 v[8];
#pragma unroll
          for (int k = 0; k < 8; ++k) { const int i = i0 + k * NGT; v[k] = src[i < n4 ? i : gt]; }
#pragma unroll
          for (int k = 0; k < 8; ++k) { const int i = i0 + k * NGT; if (i < n4) { u32x2 w; w.x = cvt_pk_bf16(v[k][0], v[k][1]); w.y = cvt_pk_bf16(v[k][2], v[k][3]); dst[i] = w; } } } }
    { const float* lg = pp->in[14]; float* lb = (float*)(ws + OFF_LB);
      for (int c = gt; c < DM; c += NGT) { const float a0 = lg[c], a1 = lg[DM + c], a2 = lg[2 * DM + c], a3 = lg[3 * DM + c]; const float mx = fmaxf(fmaxf(a0, a1), fmaxf(a2, a3));
          const float e0 = expf(a0 - mx), e1 = expf(a1 - mx), e2 = expf(a2 - mx), e3 = expf(a3 - mx); const float inv = 1.f / (e0 + e1 + e2 + e3);
          lb[c] = 0.f; lb[DM + c] = e1 * inv; lb[2 * DM + c] = (e1 + e2) * inv; lb[3 * DM + c] = (e1 + e2 + e3) * inv; } }
    { const int* pos = (const int*)pp->in[2]; float* ct = (float*)(ws + OFF_ROPE); float* st = ct + M * 32;
      for (int i = gt; i < M * 32; i += NGT) { const int r = i >> 5, f = i & 31; const float inv = exp2f(-(float)f * (13.287712379549449f / 32.f)); const float ang = (float)pos[r] * inv;
          const double a = (double)ang; const double k = rint(a * 0.15915494309189535); const float rr = (float)(a - k * 6.283185307179586);
          ct[i] = __cosf(rr); st[i] = __sinf(rr); } }
}


__device__ __forceinline__ void norm_rope_192(float (&x)[3][8], const float (&gn)[3][8], const float (&cs)[8], const float (&sn)[8], int sub, float outscale) {
    float ss = 0.f;
#pragma unroll
    for (int g = 0; g < 3; ++g)
#pragma unroll
        for (int j = 0; j < 8; ++j) ss += x[g][j] * x[g][j];
    ss += __shfl_xor(ss, 1); ss += __shfl_xor(ss, 2); ss += __shfl_xor(ss, 4);
    const float rs = rsqrtf(ss * (1.f / 192.f) + EPS);
#pragma unroll
    for (int g = 0; g < 3; ++g)
#pragma unroll
        for (int j = 0; j < 8; ++j) x[g][j] = x[g][j] * rs * gn[g][j];
#pragma unroll
    for (int j = 0; j < 8; ++j) { const float mine = x[2][j], other = __shfl_xor(mine, 4);
        x[2][j] = (sub < 4) ? (mine * cs[j] - other * sn[j]) : (mine * cs[j] + other * sn[j]); }
#pragma unroll
    for (int g = 0; g < 3; ++g)
#pragma unroll
        for (int j = 0; j < 8; ++j) x[g][j] *= outscale;
}

__device__ __forceinline__ void mla_prep(PP pp, LAS unsigned char* lds, int G, int bid, int tid_in, int j) {
    unsigned char* ws = pp->ws;
    const bf16_t* qraw = (const bf16_t*)(ws + S_QRAW); const bf16_t* kvraw = (const bf16_t*)(ws + S_KVRAW); const bf16_t* cc = (const bf16_t*)(ws + S_C);
    bf16_t* Q = (bf16_t*)(ws + S_Q); bf16_t* Kd = (bf16_t*)(ws + S_K); bf16_t* Vt = (bf16_t*)(ws + S_VT);
    const float* gq = pp->in[11] + j * 192; const float* gk = pp->in[12] + j * 192;
    const float* ct = (const float*)(ws + OFF_ROPE); const float* st = ct + M * 32;
    const int tid = tid_in, t = tid >> 3, sub = tid & 7;
    LAS bf16_t* Vl = (LAS bf16_t*)lds;
    const float qscale = 0.07216878364870322f * 1.4426950408889634f;
    float gnq[3][8], gnk[3][8];
#pragma unroll
    for (int g = 0; g < 3; ++g)
#pragma unroll
        for (int hf2 = 0; hf2 < 2; ++hf2) { const f32x4 a = *(const f32x4*)(gq + 64 * g + 8 * sub + 4 * hf2), c = *(const f32x4*)(gk + 64 * g + 8 * sub + 4 * hf2);
#pragma unroll
            for (int j = 0; j < 4; ++j) { gnq[g][4 * hf2 + j] = a[j]; gnk[g][4 * hf2 + j] = c[j]; } }
    for (int it = bid; it < 128 * 16; it += G) {
        const int tb = it >> 4, h = it & 15; const int row = tb * 64 + t, b = row >> 11, s = row & 2047;
        u32x4 rq[3], rk[3], rv[2];
#pragma unroll
        for (int g = 0; g < 3; ++g) rq[g] = *(const u32x4*)(qraw + (size_t)row * NQ + h * 192 + 64 * g + 8 * sub);
#pragma unroll
        for (int g = 0; g < 2; ++g) rk[g] = *(const u32x4*)(kvraw + (size_t)row * NKV + h * 256 + 64 * g + 8 * sub);
        rk[2] = *(const u32x4*)(cc + (size_t)row * CA + 1024 + 8 * sub);
        { const bf16_t* vp = kvraw + (size_t)row * NKV + h * 256 + 128 + 16 * sub; rv[0] = *(const u32x4*)vp; rv[1] = *(const u32x4*)(vp + 8); }
        float cs[8], sn[8];
        { const int i0 = 8 * (sub & 3); const f32x4 c0 = *(const f32x4*)(ct + row * 32 + i0), c1 = *(const f32x4*)(ct + row * 32 + i0 + 4), s0 = *(const f32x4*)(st + row * 32 + i0), s1 = *(const f32x4*)(st + row * 32 + i0 + 4);
#pragma unroll
          for (int j = 0; j < 4; ++j) { cs[j] = c0[j]; cs[4 + j] = c1[j]; sn[j] = s0[j]; sn[4 + j] = s1[j]; } }
        float x[3][8];
#pragma unroll
        for (int g = 0; g < 3; ++g) unpack8(rq[g], x[g]);
        norm_rope_192(x, gnq, cs, sn, sub, qscale);
        bf16_t* qo = Q + ((size_t)(b * NH + h) * SEQ + s) * 192 + 8 * sub;
#pragma unroll
        for (int g = 0; g < 3; ++g) store8(qo + 64 * g, x[g]);
#pragma unroll
        for (int g = 0; g < 3; ++g) unpack8(rk[g], x[g]);
        norm_rope_192(x, gnk, cs, sn, sub, 1.f);
        bf16_t* ko = Kd + ((size_t)(b * NH + h) * SEQ + s) * 192 + 8 * sub;
#pragma unroll
        for (int g = 0; g < 3; ++g) store8(ko + 64 * g, x[g]);
        { const u32x4 w0 = rv[0], w1 = rv[1];
          LAS u32x2* d = (LAS u32x2*)(Vl + t * 132 + 16 * sub); d[0] = (u32x2){w0.x, w0.y}; d[1] = (u32x2){w0.z, w0.w}; d[2] = (u32x2){w1.x, w1.y}; d[3] = (u32x2){w1.z, w1.w}; }
        __syncthreads();
        { const int d = tid >> 2, qd = tid & 3; unsigned w[8];
#pragma unroll
          for (int pp = 0; pp < 8; ++pp) { const int p0 = 2 * pp, p1 = 2 * pp + 1; const int o0 = (p0 & 3) | ((p0 & 4) << 1) | ((p0 & 8) >> 1), o1 = (p1 & 3) | ((p1 & 4) << 1) | ((p1 & 8) >> 1);
              w[pp] = (unsigned)Vl[(16 * qd + o0) * 132 + d] | ((unsigned)Vl[(16 * qd + o1) * 132 + d] << 16); }
          bf16_t* vo = Vt + ((size_t)(b * NH + h) * 128 + d) * SEQ + (tb * 64 & 2047) + 16 * qd;
          *(u32x4*)vo = (u32x4){w[0], w[1], w[2], w[3]}; *(u32x4*)(vo + 8) = (u32x4){w[4], w[5], w[6], w[7]}; }
        __syncthreads();
    }
}

constexpr int AT_KROW = 400, AT_VROW = 144, AT_KBYTES = 64 * AT_KROW, AT_BUF = 45056;
__device__ __forceinline__ void attn_unit(LAS unsigned char* lds, const bf16_t* Q, const bf16_t* K, const bf16_t* Vt, bf16_t* O, int bh, int qb, int tid, int wid, int lane) {
    const int r = lane & 31, hh = lane >> 5;
    const int q0 = qb * 256 + wid * 32;
    const bf16_t* Qp = Q + ((size_t)bh * SEQ + q0 + r) * 192 + 8 * hh;
    bf16x8 qf[12];
#pragma unroll
    for (int ks = 0; ks < 12; ++ks) qf[ks] = *(const bf16x8*)(Qp + 16 * ks);
    f32x16 o[4];
#pragma unroll
    for (int dt = 0; dt < 4; ++dt)
#pragma unroll
        for (int i = 0; i < 16; ++i) o[dt][i] = 0.f;
    float m_run = -1e30f, l_run = 0.f;
    const int ntiles = 4 * (qb + 1);
    const bf16_t* Kg = K + (size_t)bh * SEQ * 192; const bf16_t* Vg = Vt + (size_t)bh * 128 * SEQ;
    u32x4 kst[3], vst[2];
#define AT_LOAD(t) do { _Pragma("unroll") for (int i = 0; i < 3; ++i) kst[i] = *((const u32x4*)(Kg + (size_t)(t) * 64 * 192) + tid + 512 * i); \
        _Pragma("unroll") for (int i = 0; i < 2; ++i) { const int c = tid + 512 * i; vst[i] = *(const u32x4*)(Vg + (size_t)(c >> 3) * SEQ + (t) * 64 + (c & 7) * 8); } } while (0)
#define AT_WRITE(buf) do { _Pragma("unroll") for (int i = 0; i < 3; ++i) { const int c = tid + 512 * i; *(LAS u32x4*)(lds + (buf) * AT_BUF + (c / 24) * AT_KROW + (c % 24) * 16) = kst[i]; } \
        _Pragma("unroll") for (int i = 0; i < 2; ++i) { const int c = tid + 512 * i; *(LAS u32x4*)(lds + (buf) * AT_BUF + AT_KBYTES + (c >> 3) * AT_VROW + (c & 7) * 16) = vst[i]; } } while (0)
    AT_LOAD(0); AT_WRITE(0); __syncthreads();
    for (int t = 0; t < ntiles; ++t) {
        if (t + 1 < ntiles) AT_LOAD(t + 1);
        if (64 * t <= q0 + 31) {
            const LAS unsigned char* Kb = lds + (t & 1) * AT_BUF; const LAS unsigned char* Vb = Kb + AT_KBYTES;
            f32x16 s[2];
#pragma unroll
            for (int st = 0; st < 2; ++st) {
#pragma unroll
                for (int i = 0; i < 16; ++i) s[st][i] = 0.f;
#pragma unroll
                for (int kg = 0; kg < 3; ++kg) { bf16x8 a[4];
#pragma unroll
                    for (int k2 = 0; k2 < 4; ++k2) a[k2] = *(const LAS bf16x8*)(Kb + (32 * st + r) * AT_KROW + 32 * (4 * kg + k2) + 16 * hh);
#pragma unroll
                    for (int k2 = 0; k2 < 4; ++k2) s[st] = __builtin_amdgcn_mfma_f32_32x32x16_bf16(a[k2], qf[4 * kg + k2], s[st], 0, 0, 0);
                    __builtin_amdgcn_sched_barrier(0); }
            }
            if (64 * t + 63 > q0) {
                const int qg = q0 + r;
#pragma unroll
                for (int st = 0; st < 2; ++st)
#pragma unroll
                    for (int i = 0; i < 16; ++i) { const int kv = 64 * t + 32 * st + (i & 3) + 8 * (i >> 2) + 4 * hh; if (kv > qg) s[st][i] = -INFINITY; }
            }
            float mx = s[0][0];
#pragma unroll
            for (int st = 0; st < 2; ++st)
#pragma unroll
                for (int i = 0; i < 16; ++i) mx = fmaxf(mx, s[st][i]);
            mx = fmaxf(mx, __shfl_xor(mx, 32));
            const float m_new = fmaxf(m_run, mx); const float alpha = __builtin_amdgcn_exp2f(m_run - m_new); m_run = m_new;
            float ls = 0.f;
#pragma unroll
            for (int st = 0; st < 2; ++st)
#pragma unroll
                for (int i = 0; i < 16; ++i) { s[st][i] = __builtin_amdgcn_exp2f(s[st][i] - m_new); ls += s[st][i]; }
            l_run = l_run * alpha + ls;
#pragma unroll
            for (int dt = 0; dt < 4; ++dt)
#pragma unroll
                for (int i = 0; i < 16; ++i) o[dt][i] *= alpha;
            bf16x8 pf[2][2];
#pragma unroll
            for (int st = 0; st < 2; ++st)
#pragma unroll
                for (int s2 = 0; s2 < 2; ++s2) { u32x4 w; w.x = cvt_pk_bf16(s[st][8 * s2 + 0], s[st][8 * s2 + 1]); w.y = cvt_pk_bf16(s[st][8 * s2 + 2], s[st][8 * s2 + 3]);
                    w.z = cvt_pk_bf16(s[st][8 * s2 + 4], s[st][8 * s2 + 5]); w.w = cvt_pk_bf16(s[st][8 * s2 + 6], s[st][8 * s2 + 7]); pf[st][s2] = __builtin_bit_cast(bf16x8, w); }
#pragma unroll
            for (int dt = 0; dt < 4; ++dt) { bf16x8 a[4];
#pragma unroll
                for (int k2 = 0; k2 < 4; ++k2) a[k2] = *(const LAS bf16x8*)(Vb + (32 * dt + r) * AT_VROW + (16 * k2 + 8 * hh) * 2);
#pragma unroll
                for (int k2 = 0; k2 < 4; ++k2) o[dt] = __builtin_amdgcn_mfma_f32_32x32x16_bf16(a[k2], pf[k2 >> 1][k2 & 1], o[dt], 0, 0, 0);
                __builtin_amdgcn_sched_barrier(0); }
        }
        if (t + 1 < ntiles) AT_WRITE((t + 1) & 1);
        __syncthreads();
    }
#undef AT_LOAD
#undef AT_WRITE
    const float l = l_run + __shfl_xor(l_run, 32); const float inv = 1.f / l;
    const int b = bh >> 4, head = bh & 15;
    bf16_t* op = O + ((size_t)(b * SEQ + q0 + r)) * DM + head * 128 + 4 * hh;
#pragma unroll
    for (int dt = 0; dt < 4; ++dt)
#pragma unroll
        for (int i4 = 0; i4 < 4; ++i4) { u32x2 w; w.x = cvt_pk_bf16(o[dt][4 * i4] * inv, o[dt][4 * i4 + 1] * inv); w.y = cvt_pk_bf16(o[dt][4 * i4 + 2] * inv, o[dt][4 * i4 + 3] * inv);
            *(u32x2*)(op + 32 * dt + 8 * i4) = w; }
}
__device__ __forceinline__ void attn_phase(PP pp, LAS unsigned char* lds, int G, int bid, int tid_in) {
    unsigned char* ws = pp->ws;
    const bf16_t* Q = (const bf16_t*)(ws + S_Q); const bf16_t* K = (const bf16_t*)(ws + S_K); const bf16_t* Vt = (const bf16_t*)(ws + S_VT); bf16_t* O = (bf16_t*)(ws + S_O);
    const int tid = tid_in, wid = __builtin_amdgcn_readfirstlane(tid >> 6), lane = tid & 63;
    for (int pr = bid; pr < 256; pr += G) {
        const int bh = pr >> 2, qa = pr & 3;
        attn_unit(lds, Q, K, Vt, O, bh, 7 - qa, tid, wid, lane);
        attn_unit(lds, Q, K, Vt, O, bh, qa, tid, wid, lane);
    }
}

constexpr int BFS = 132;
constexpr int HG_SEG = 34816, HG_AFTER_SEG = 43008;
__device__ __forceinline__ void hg_cumsum(LAS float* BF, LAS float* SEG, const u32x4 (&lf)[2], int tid) {
#pragma unroll
    for (int i = 0; i < 2; ++i) { const int c = tid + 512 * i; LAS float* d = BF + (c >> 4) * BFS + (c & 15) * 8; const u32x4 w = lf[i];
        *(LAS f32x4*)d = (f32x4){f16_lo(w.x), f16_hi(w.x), f16_lo(w.y), f16_hi(w.y)}; *(LAS f32x4*)(d + 4) = (f32x4){f16_lo(w.z), f16_hi(w.z), f16_lo(w.w), f16_hi(w.w)}; }
    __syncthreads();
    const int d4 = (tid & 31) * 4, sg = tid >> 5;
    f32x4 r[4];
#pragma unroll
    for (int k = 0; k < 4; ++k) r[k] = *(const LAS f32x4*)(BF + (4 * sg + k) * BFS + d4);
    r[1] += r[0]; r[2] += r[1]; r[3] += r[2];
    *(LAS f32x4*)(SEG + sg * 128 + d4) = r[3];
    __syncthreads();
    f32x4 pre = (f32x4){0.f, 0.f, 0.f, 0.f};
#pragma unroll
    for (int s2 = 0; s2 < 15; ++s2) if (s2 < sg) pre += *(const LAS f32x4*)(SEG + s2 * 128 + d4);
#pragma unroll
    for (int k = 0; k < 4; ++k) *(LAS f32x4*)(BF + (4 * sg + k) * BFS + d4) = r[k] + pre;
    __syncthreads();
}
__device__ __forceinline__ void ld8f(const LAS float* p, float (&v)[8]) { const f32x4 a = *(const LAS f32x4*)p, b = *(const LAS f32x4*)(p + 4); v[0] = a[0]; v[1] = a[1]; v[2] = a[2]; v[3] = a[3]; v[4] = b[0]; v[5] = b[1]; v[6] = b[2]; v[7] = b[3]; }
__device__ __forceinline__ void hgrn_phaseA(PP pp, LAS unsigned char* lds, int G, int bid, int tid_in) {
    unsigned char* ws = pp->ws;
    const bf16_t* logf = (const bf16_t*)(ws + S_LOGF); const bf16_t* kk = (const bf16_t*)(ws + S_KK); const bf16_t* vv = (const bf16_t*)(ws + S_V);
    bf16_t* UT = (bf16_t*)(ws + S_UT); float* Gd = (float*)(ws + OFF_G);
    const int tid = tid_in, wid = __builtin_amdgcn_readfirstlane(tid >> 6), lane = tid & 63, fr = lane & 15, fg = lane >> 4;
    LAS float* BF = (LAS float*)lds; LAS float* SEG = (LAS float*)(lds + HG_SEG);
    LAS bf16_t* KhT = (LAS bf16_t*)(lds + HG_AFTER_SEG); LAS bf16_t* vT = (LAS bf16_t*)(lds + HG_AFTER_SEG + 18432);
    const int sp = tid & 31, d8 = (tid >> 5) * 8;
    u32x4 lf[2]; u32x4 vq[2];
#define HA_LOAD(IT) do { const int bh_ = (IT) >> 5, c_ = (IT) & 31; const int r0_ = (bh_ >> 4) * SEQ + c_ * 64, c0_ = (bh_ & 15) * 128; \
        _Pragma("unroll") for (int i = 0; i < 2; ++i) { const int c = tid + 512 * i; lf[i] = *(const u32x4*)(logf + (size_t)(r0_ + (c >> 4)) * DM + c0_ + (c & 15) * 8); } \
        _Pragma("unroll") for (int i = 0; i < 2; ++i) { const size_t o_ = (size_t)(r0_ + 2 * sp + i) * DM + c0_ + d8; vq[i] = *(const u32x4*)(vv + o_); } } while (0)
    int it = bid;
    if (it < 2048) HA_LOAD(it);
    for (; it < 2048; it += G) {
        hg_cumsum(BF, SEG, lf, tid);
        if (tid < 128) Gd[(size_t)it * 128 + tid] = __expf(BF[63 * BFS + tid]);
        { float v0[8], v1[8], bl[8], bm[8], b0[8], b1[8]; unpack8(vq[0], v0); unpack8(vq[1], v1);
          ld8f(BF + 63 * BFS + d8, bl); ld8f(BF + (2 * sp) * BFS + d8, b0); ld8f(BF + (2 * sp + 1) * BFS + d8, b1);
          if (sp > 0) ld8f(BF + (2 * sp - 1) * BFS + d8, bm); else {
#pragma unroll
              for (int j = 0; j < 8; ++j) bm[j] = 0.f; }
#pragma unroll
          for (int j = 0; j < 8; ++j) { const float k0 = 1.f - __expf(b0[j] - bm[j]), k1 = 1.f - __expf(b1[j] - b0[j]);
              *(LAS unsigned*)(KhT + (d8 + j) * 72 + 2 * sp) = cvt_pk_bf16(k0 * __expf(bl[j] - b0[j]), k1 * __expf(bl[j] - b1[j]));
              *(LAS unsigned*)(vT + (d8 + j) * 72 + 2 * sp) = cvt_pk_bf16(v0[j], v1[j]); } }
        __syncthreads();
        if (it + G < 2048) HA_LOAD(it + G);
        f32x4 acc[8];
#pragma unroll
        for (int et = 0; et < 8; ++et) acc[et] = (f32x4){0.f, 0.f, 0.f, 0.f};
#pragma unroll
        for (int ks = 0; ks < 2; ++ks) { const bf16x8 a = *(const LAS bf16x8*)(KhT + (16 * wid + fr) * 72 + 32 * ks + 8 * fg);
#pragma unroll
            for (int et = 0; et < 8; ++et) { const bf16x8 bb = *(const LAS bf16x8*)(vT + (16 * et + fr) * 72 + 32 * ks + 8 * fg); acc[et] = __builtin_amdgcn_mfma_f32_16x16x32_bf16(a, bb, acc[et], 0, 0, 0); } }
        bf16_t* uo = UT + (size_t)it * 16384 + 16 * wid + 4 * fg;
#pragma unroll
        for (int et = 0; et < 8; ++et) { u32x2 w; w.x = pk_f16(acc[et][0], acc[et][1]); w.y = pk_f16(acc[et][2], acc[et][3]); *(u32x2*)(uo + (size_t)(16 * et + fr) * 128) = w; }
        __syncthreads();
    }
#undef HA_LOAD
}
__device__ __forceinline__ void hgrn_phaseB(PP pp, int G, int bid, int tid_in) {
    unsigned char* ws = pp->ws;
    const bf16_t* UT = (const bf16_t*)(ws + S_UT); const float* Gd = (const float*)(ws + OFF_G); bf16_t* SP = (bf16_t*)(ws + S_SP);
    for (int idx = bid * 512 + tid_in; idx < 64 * 128 * 32; idx += G * 512) {
        const int d4 = idx & 31, e = (idx >> 5) & 127, bh = idx >> 12; f32x4 S = (f32x4){0.f, 0.f, 0.f, 0.f};
        for (int c0 = 0; c0 < 32; c0 += 16) {
            f32x4 gq[16]; u32x2 uq[16];
#pragma unroll
            for (int k = 0; k < 16; ++k) { const size_t it = (size_t)bh * 32 + c0 + k; gq[k] = *(const f32x4*)(Gd + it * 128 + 4 * d4); uq[k] = *(const u32x2*)(UT + it * 16384 + e * 128 + 4 * d4); }
#pragma unroll
            for (int k = 0; k < 16; ++k) { const size_t o = ((size_t)bh * 32 + c0 + k) * 16384 + e * 128 + 4 * d4;
                u32x2 w; w.x = cvt_pk_bf16(S[0], S[1]); w.y = cvt_pk_bf16(S[2], S[3]); *(u32x2*)(SP + o) = w;
                S[0] = gq[k][0] * S[0] + f16_lo(uq[k].x); S[1] = gq[k][1] * S[1] + f16_hi(uq[k].x); S[2] = gq[k][2] * S[2] + f16_lo(uq[k].y); S[3] = gq[k][3] * S[3] + f16_hi(uq[k].y); }
        }
    }
}
__device__ __forceinline__ void hgrn_phaseC(PP pp, LAS unsigned char* lds, int G, int bid, int tid_in, int j) {
    unsigned char* ws = pp->ws;
    const bf16_t* logf = (const bf16_t*)(ws + S_LOGF); const bf16_t* kk = (const bf16_t*)(ws + S_KK); const bf16_t* vv = (const bf16_t*)(ws + S_V);
    const bf16_t* qs = (const bf16_t*)(ws + S_QS); const bf16_t* gs = (const bf16_t*)(ws + S_GS); const bf16_t* SP = (const bf16_t*)(ws + S_SP); bf16_t* OG = (bf16_t*)(ws + S_OG);
    const float* onorm = pp->in[16] + j * DM;
    const int tid = tid_in, wid = __builtin_amdgcn_readfirstlane(tid >> 6), lane = tid & 63, fr = lane & 15, fg = lane >> 4;
    LAS float* BF = (LAS float*)lds; LAS bf16_t* SpT = (LAS bf16_t*)lds;
    LAS float* SEG = (LAS float*)(lds + HG_SEG);
    LAS bf16_t* Qh = (LAS bf16_t*)(lds + 43008); LAS bf16_t* Qt = (LAS bf16_t*)(lds + 60416); LAS bf16_t* Kt = (LAS bf16_t*)(lds + 77824);
    LAS bf16_t* vT = (LAS bf16_t*)(lds + 95232);
    LAS bf16_t* Ab = (LAS bf16_t*)(lds + 113664);
    LAS float* SSQ = (LAS float*)(lds + 122880);
    const int sp2 = tid & 31, e8v = (tid >> 5) * 8;
    u32x4 lf[2]; u32x4 q2[2], v2[2], sp[4];
#define HC_LOAD(IT) do { const int bh_ = (IT) >> 5, c_ = (IT) & 31; const int r0_ = (bh_ >> 4) * SEQ + c_ * 64, c0_ = (bh_ & 15) * 128; \
        _Pragma("unroll") for (int i = 0; i < 2; ++i) { const int c = tid + 512 * i; lf[i] = *(const u32x4*)(logf + (size_t)(r0_ + (c >> 4)) * DM + c0_ + (c & 15) * 8); } \
        _Pragma("unroll") for (int i = 0; i < 2; ++i) { const int cx = tid + 512 * i; const size_t o_ = (size_t)(r0_ + (cx >> 4)) * DM + c0_ + (cx & 15) * 8; q2[i] = *(const u32x4*)(qs + o_); \
            v2[i] = *(const u32x4*)(vv + (size_t)(r0_ + 2 * sp2 + i) * DM + c0_ + e8v); } \
        _Pragma("unroll") for (int i = 0; i < 4; ++i) { const int cx = tid + 512 * i; sp[i] = *(const u32x4*)(SP + (size_t)(IT) * 16384 + (cx >> 4) * 128 + (cx & 15) * 8); } } while (0)
    int it = bid;
    if (it < 2048) HC_LOAD(it);
    for (; it < 2048; it += G) {
        const int bh = it >> 5, c = it & 31, b = bh >> 4, head = bh & 15; const int row0 = b * SEQ + c * 64, col0 = head * 128;
        hg_cumsum(BF, SEG, lf, tid);
#pragma unroll
        for (int i = 0; i < 2; ++i) { const int cx = tid + 512 * i, t = cx >> 4, d8 = (cx & 15) * 8; float q8[8], bt[8], bp[8], br[8], a[8], bq[8], ck[8]; unpack8(q2[i], q8);
            ld8f(BF + t * BFS + d8, bt); ld8f(BF + 31 * BFS + d8, br);
            if (t > 0) ld8f(BF + (t - 1) * BFS + d8, bp); else {
#pragma unroll
                for (int jj = 0; jj < 8; ++jj) bp[jj] = 0.f; }
#pragma unroll
            for (int jj = 0; jj < 8; ++jj) { const float k8 = 1.f - __expf(bt[jj] - bp[jj]);
                a[jj] = q8[jj] * __expf(bt[jj]); bq[jj] = q8[jj] * __expf(fminf(bt[jj] - br[jj], 80.f)); ck[jj] = k8 * __expf(fminf(br[jj] - bt[jj], 80.f)); }
            LAS u32x4* d0 = (LAS u32x4*)(Qh + t * 136 + d8); LAS u32x4* d1 = (LAS u32x4*)(Qt + t * 136 + d8); LAS u32x4* d2 = (LAS u32x4*)(Kt + t * 136 + d8);
            u32x4 w; w.x = cvt_pk_bf16(a[0], a[1]); w.y = cvt_pk_bf16(a[2], a[3]); w.z = cvt_pk_bf16(a[4], a[5]); w.w = cvt_pk_bf16(a[6], a[7]); *d0 = w;
            w.x = cvt_pk_bf16(bq[0], bq[1]); w.y = cvt_pk_bf16(bq[2], bq[3]); w.z = cvt_pk_bf16(bq[4], bq[5]); w.w = cvt_pk_bf16(bq[6], bq[7]); *d1 = w;
            w.x = cvt_pk_bf16(ck[0], ck[1]); w.y = cvt_pk_bf16(ck[2], ck[3]); w.z = cvt_pk_bf16(ck[4], ck[5]); w.w = cvt_pk_bf16(ck[6], ck[7]); *d2 = w; }
        { const u32x4 w0 = v2[0], w1 = v2[1];
          LAS unsigned* vd = (LAS unsigned*)(vT + e8v * 72 + 2 * sp2);
          vd[0 * 36] = (w0.x & 0xffffu) | (w1.x << 16); vd[1 * 36] = (w0.x >> 16) | (w1.x & 0xffff0000u); vd[2 * 36] = (w0.y & 0xffffu) | (w1.y << 16); vd[3 * 36] = (w0.y >> 16) | (w1.y & 0xffff0000u);
          vd[4 * 36] = (w0.z & 0xffffu) | (w1.z << 16); vd[5 * 36] = (w0.z >> 16) | (w1.z & 0xffff0000u); vd[6 * 36] = (w0.w & 0xffffu) | (w1.w << 16); vd[7 * 36] = (w0.w >> 16) | (w1.w & 0xffff0000u); }
        __syncthreads();
#pragma unroll
        for (int i = 0; i < 4; ++i) { const int cx = tid + 512 * i, e = cx >> 4, d8 = (cx & 15) * 8; *(LAS u32x4*)(SpT + e * 136 + d8) = sp[i]; }
        const int tt = wid & 3, eh = wid >> 2; const int t = 16 * tt + fr;
        u32x2 gv[4]; f32x4 on[4];
#pragma unroll
        for (int jj = 0; jj < 4; ++jj) { const int e0 = 16 * (4 * eh + jj) + 4 * fg; on[jj] = *(const f32x4*)(onorm + col0 + e0); gv[jj] = *(const u32x2*)(gs + (size_t)(row0 + t) * DM + col0 + e0); }
        if (it + G < 2048) HC_LOAD(it + G);
        { const int sh = wid >> 2; f32x4 a2[2] = {(f32x4){0.f, 0.f, 0.f, 0.f}, (f32x4){0.f, 0.f, 0.f, 0.f}};
#pragma unroll
          for (int ks = 0; ks < 4; ++ks) { const bf16x8 qf = *(const LAS bf16x8*)(Qt + (16 * tt + fr) * 136 + 32 * ks + 8 * fg);
#pragma unroll
              for (int jj = 0; jj < 2; ++jj) { const bf16x8 kf = *(const LAS bf16x8*)(Kt + (16 * (2 * sh + jj) + fr) * 136 + 32 * ks + 8 * fg); a2[jj] = __builtin_amdgcn_mfma_f32_16x16x32_bf16(kf, qf, a2[jj], 0, 0, 0); } }
#pragma unroll
          for (int jj = 0; jj < 2; ++jj) { const int s0 = 16 * (2 * sh + jj) + 4 * fg; u32x2 w;
              w.x = cvt_pk_bf16(s0 + 0 <= t ? a2[jj][0] : 0.f, s0 + 1 <= t ? a2[jj][1] : 0.f); w.y = cvt_pk_bf16(s0 + 2 <= t ? a2[jj][2] : 0.f, s0 + 3 <= t ? a2[jj][3] : 0.f);
              *(LAS u32x2*)(Ab + t * 72 + s0) = w; } }
        __syncthreads();
        { f32x4 acc[4];
#pragma unroll
          for (int jj = 0; jj < 4; ++jj) acc[jj] = (f32x4){0.f, 0.f, 0.f, 0.f};
#pragma unroll
          for (int ks = 0; ks < 4; ++ks) { const bf16x8 qf = *(const LAS bf16x8*)(Qh + (16 * tt + fr) * 136 + 32 * ks + 8 * fg);
#pragma unroll
              for (int jj = 0; jj < 4; ++jj) { const bf16x8 sf = *(const LAS bf16x8*)(SpT + (16 * (4 * eh + jj) + fr) * 136 + 32 * ks + 8 * fg); acc[jj] = __builtin_amdgcn_mfma_f32_16x16x32_bf16(sf, qf, acc[jj], 0, 0, 0); } }
#pragma unroll
          for (int ks = 0; ks < 2; ++ks) { const bf16x8 af = *(const LAS bf16x8*)(Ab + (16 * tt + fr) * 72 + 32 * ks + 8 * fg);
#pragma unroll
              for (int jj = 0; jj < 4; ++jj) { const bf16x8 vf = *(const LAS bf16x8*)(vT + (16 * (4 * eh + jj) + fr) * 72 + 32 * ks + 8 * fg); acc[jj] = __builtin_amdgcn_mfma_f32_16x16x32_bf16(vf, af, acc[jj], 0, 0, 0); } }
          float s2 = 0.f;
#pragma unroll
          for (int jj = 0; jj < 4; ++jj) s2 += dot4(acc[jj]);
          s2 += __shfl_xor(s2, 16); s2 += __shfl_xor(s2, 32);
          if (fg == 0) SSQ[t * 2 + eh] = s2;
          __syncthreads();
          const float rs = rsqrtf((SSQ[t * 2] + SSQ[t * 2 + 1]) * (1.f / 128.f) + EPS);
#pragma unroll
          for (int jj = 0; jj < 4; ++jj) { const int e0 = 16 * (4 * eh + jj) + 4 * fg; u32x2 w;
              w.x = cvt_pk_bf16(acc[jj][0] * rs * on[jj][0] * bf_lo(gv[jj].x), acc[jj][1] * rs * on[jj][1] * bf_hi(gv[jj].x));
              w.y = cvt_pk_bf16(acc[jj][2] * rs * on[jj][2] * bf_lo(gv[jj].y), acc[jj][3] * rs * on[jj][3] * bf_hi(gv[jj].y));
              *(u32x2*)(OG + (size_t)(row0 + t) * DM + col0 + e0) = w; } }
        __syncthreads();
    }
#undef HC_LOAD
}

__device__ __forceinline__ void ffn_fixup(PP pp, int pm, int tid_in, int layer) {
    unsigned char* ws = pp->ws;
    const bf16_t* gate = (const bf16_t*)(ws + S_GATE); const bf16_t* up = (const bf16_t*)(ws + S_UP); bf16_t* act = (bf16_t*)(ws + S_ACT);
    const float* cw = pp->in[19] + (size_t)layer * 3 * DFF; const float* cb = pp->in[20] + (size_t)layer * DFF;
    constexpr int NCH = DFF / 8;
    for (int idx = tid_in; idx < 2 * NCH; idx += 512) {
        const int ch = idx % NCH, sp = idx / NCH; const int col = ch * 8;
        float w0[8], w1[8], w2[8], bb[8];
#pragma unroll
        for (int h = 0; h < 2; ++h) { const f32x4 a = *(const f32x4*)(cw + col + 4 * h), b = *(const f32x4*)(cw + DFF + col + 4 * h), c = *(const f32x4*)(cw + 2 * DFF + col + 4 * h), d = *(const f32x4*)(cb + col + 4 * h);
#pragma unroll
            for (int j = 0; j < 4; ++j) { w0[4 * h + j] = a[j]; w1[4 * h + j] = b[j]; w2[4 * h + j] = c[j]; bb[4 * h + j] = d[j]; } }
        {
            u32x4 gq[2][4], uq[2][2];
#pragma unroll
            for (int s2 = 0; s2 < 2; ++s2) { const int row0 = pm * 256 + (2 * sp + s2) * 64; const bool first = (row0 & 2047) == 0;
                const size_t o0 = (size_t)row0 * DFF + col; const size_t om2 = first ? o0 : o0 - 2 * (size_t)DFF, om1 = first ? o0 : o0 - (size_t)DFF;
                gq[s2][0] = *(const u32x4*)(gate + om2); gq[s2][1] = *(const u32x4*)(gate + om1); gq[s2][2] = *(const u32x4*)(gate + o0); gq[s2][3] = *(const u32x4*)(gate + o0 + DFF);
                uq[s2][0] = *(const u32x4*)(up + o0); uq[s2][1] = *(const u32x4*)(up + o0 + DFF); }
#pragma unroll
            for (int s2 = 0; s2 < 2; ++s2) { const int row0 = pm * 256 + (2 * sp + s2) * 64; const bool first = (row0 & 2047) == 0; const size_t o0 = (size_t)row0 * DFF + col;
                float g0[8], g1[8], g2[8], g3[8], u0[8], u1[8], oa[8], ob[8];
                load8((const bf16_t*)&gq[s2][0], g0); load8((const bf16_t*)&gq[s2][1], g1); load8((const bf16_t*)&gq[s2][2], g2); load8((const bf16_t*)&gq[s2][3], g3);
                load8((const bf16_t*)&uq[s2][0], u0); load8((const bf16_t*)&uq[s2][1], u1);
#pragma unroll
                for (int j = 0; j < 8; ++j) { const float p2 = first ? 0.f : g0[j], p1 = first ? 0.f : g1[j];
                    const float ca = bb[j] + w0[j] * p2 + w1[j] * p1 + w2[j] * g2[j]; oa[j] = ca * sigmoidf_(ca) * u0[j];
                    const float cc = bb[j] + w0[j] * p1 + w1[j] * g2[j] + w2[j] * g3[j]; ob[j] = cc * sigmoidf_(cc) * u1[j]; }
                store8(act + o0, oa); store8(act + o0 + DFF, ob); }
        }
    }
    asm volatile("s_waitcnt vmcnt(0)" ::: "memory");
    __syncthreads();
}

constexpr int NPHASES = 33;
constexpr size_t OFF_BAR = 6 * MiB;
#define XB_TMO      128
#define XB_XCNT(j)  (256  + 64 * (j))
#define XB_XSUB(j)  (1280 + 64 * (j))
#define XB_XGEN(j)  (2304 + 64 * (j))
#define XB_TOP      3328
#define XB_TOPGEN   3392
#define XCD_BAR_WORDS 3456
#define XB_SPIN_CAP (1u << 22)
__device__ __forceinline__ unsigned xb_ld(unsigned* p)              { return __hip_atomic_load(p, __ATOMIC_RELAXED, __HIP_MEMORY_SCOPE_AGENT); }
__device__ __forceinline__ unsigned xb_add(unsigned* p, unsigned v) { return __hip_atomic_fetch_add(p, v, __ATOMIC_RELAXED, __HIP_MEMORY_SCOPE_AGENT); }
__device__ __forceinline__ unsigned xb_xcc_id() { return (unsigned)__builtin_amdgcn_s_getreg((3 << 11) | 20) & 0xFu; }
#define XB_SPIN(cond, bar) do { unsigned _sp = 0; while (cond) { __builtin_amdgcn_s_sleep(1); \
    if ((++_sp & 255u) == 0u) { if (xb_ld(&(bar)[XB_TMO])) break; if (_sp > XB_SPIN_CAP) { atomicAdd(&(bar)[XB_TMO], 1u); break; } } } } while (0)
__device__ __forceinline__ void xcd_barrier_complete(unsigned* bar, unsigned x, unsigned G, unsigned& nloc, unsigned& nx) {
    unsigned sum, cnt, mine, sp = 0u;
    for (;;) {
        sum = 0u; cnt = 0u; mine = 0u;
#pragma unroll
        for (unsigned j = 0; j < 16; ++j) { const unsigned c = xb_ld(&bar[XB_XCNT(j)]); sum += c; cnt += (c > 0u) ? 1u : 0u; mine = (j == x) ? c : mine; }
        if (sum == G) break;
        __builtin_amdgcn_s_sleep(1);
        if ((++sp & 255u) == 0u) { if (xb_ld(&bar[XB_TMO])) break; if (sp > XB_SPIN_CAP) { atomicAdd(&bar[XB_TMO], 1u); break; } }
    }
    nloc = mine > 0u ? mine : 1u; nx = cnt > 0u ? cnt : 1u;
}
__device__ __forceinline__ void grid_barrier(unsigned* bar, volatile LAS unsigned* st, unsigned G, int tid) {
    asm volatile("s_waitcnt vmcnt(0) lgkmcnt(0)" ::: "memory");
    __syncthreads();
    if (tid == 0) {
        const unsigned x = xb_xcc_id();
        __builtin_amdgcn_s_waitcnt(0);
        unsigned nloc = st[0], nx = st[1];
        if (nloc == 0u) { xcd_barrier_complete(bar, x, G, nloc, nx); st[0] = nloc; st[1] = nx; }
        const unsigned old = xb_add(&bar[XB_XSUB(x)], 1u);
        const unsigned gen = old / nloc;
        if (old + 1u == (gen + 1u) * nloc) {
            __builtin_amdgcn_fence(__ATOMIC_RELEASE, "agent");
            asm volatile("s_waitcnt vmcnt(0)" ::: "memory");
            const unsigned og = xb_add(&bar[XB_TOP], 1u);
            const unsigned tg = og / nx;
            if (og + 1u == (tg + 1u) * nx) xb_add(&bar[XB_TOPGEN], 1u);
            else XB_SPIN(xb_ld(&bar[XB_TOPGEN]) == tg, bar);
            __builtin_amdgcn_fence(__ATOMIC_ACQUIRE, "agent");
            xb_add(&bar[XB_XGEN(x)], 1u);
            asm volatile("s_waitcnt vmcnt(0)" ::: "memory");
        } else {
            XB_SPIN(xb_ld(&bar[XB_XGEN(x)]) == gen, bar);
            __builtin_amdgcn_fence(__ATOMIC_ACQUIRE, "agent");
            asm volatile("s_waitcnt vmcnt(0)" ::: "memory");
        }
    }
    __syncthreads();
}
constexpr int LDS_BARST = 131072 + 64;

#define PH_BEGIN(PHI) if ((PHI) >= lo && (PHI) < hi) { constexpr int ph_ = (PHI); PP q = pk; asm volatile("" : "+s"(q)); int G = gridDim.x, bid = (int)__builtin_amdgcn_workgroup_id_x(), wv_ = wid_s; asm volatile("" : "+s"(G), "+s"(bid), "+s"(wv_)); \
        int tid; asm volatile("v_mbcnt_lo_u32_b32 %0, -1, 0\n\tv_mbcnt_hi_u32_b32 %0, -1, %0" : "=&v"(tid)); tid += wv_ * 64; asm volatile("" : "+v"(tid)); \
        unsigned char* ws = q->ws; float* H = q->out; float* ssq = (float*)(ws + OFF_SSQ); \
        bf16_t* hbA = (bf16_t*)(ws + (cur ? OFF_HB1 : OFF_HB0)); bf16_t* hbB = (bf16_t*)(ws + (cur ? OFF_HB0 : OFF_HB1)); bf16_t* hfA = (bf16_t*)(ws + (cur ? OFF_HF1 : OFF_HF0)); bf16_t* hfB = (bf16_t*)(ws + (cur ? OFF_HF0 : OFF_HF1)); (void)H; (void)ssq; (void)hbA; (void)hbB; (void)hfA; (void)hfB; \
        for (int rep_ = 0; rep_ < ((((unsigned long long)(PROBE_MASK) >> ph_) & 1ull) ? 2 : 1); ++rep_) {
#define PH_END } if (ph_ + 1 < hi) { asm volatile("v_mbcnt_lo_u32_b32 %0, -1, 0\n\tv_mbcnt_hi_u32_b32 %0, -1, %0" : "=&v"(tid)); wv_ = wid_s; asm volatile("" : "+s"(wv_)); tid += wv_ * 64; asm volatile("" : "+v"(tid), "+s"(G), "+s"(q)); grid_barrier((unsigned*)(q->ws + OFF_BAR), (volatile LAS unsigned*)(lds + LDS_BARST), (unsigned)G, tid); } }
#define PH_RELOAD asm volatile("v_mbcnt_lo_u32_b32 %0, -1, 0\n\tv_mbcnt_hi_u32_b32 %0, -1, %0" : "=&v"(tid)); wv_ = wid_s; asm volatile("" : "+s"(wv_)); tid += wv_ * 64; asm volatile("" : "+v"(tid), "+s"(G), "+s"(bid), "+s"(q)); ws = q->ws; H = q->out; ssq = (float*)(ws + OFF_SSQ); hbA = (bf16_t*)(ws + (cur ? OFF_HB1 : OFF_HB0)); hbB = (bf16_t*)(ws + (cur ? OFF_HB0 : OFF_HB1)); hfA = (bf16_t*)(ws + (cur ? OFF_HF1 : OFF_HF0)); hfB = (bf16_t*)(ws + (cur ? OFF_HF0 : OFF_HF1));

template <int layer>
__device__ __forceinline__ void run_layer(PP pk, LAS unsigned char* lds, int lo, int hi, int wid_s) {
    constexpr int j = layer >> 1, v = 3 * layer, P0 = 1 + 8 * layer;
    int cur = layer & 1;
    if constexpr ((layer & 1) == 0) {
        PH_BEGIN(P0 + 0) { const bf16_t* Wa = (const bf16_t*)(ws + OFF_WMLA + (size_t)j * 20 * MiB);
            pg8::Gemm g{hfA, Wa, M, CA, DM, DM, DM}; pg8::StaticOrder S; S.init(M, CA, G, bid);
            pg8::EpiBf16S<true> E{(bf16_t*)(ws + S_C), CA, ssq + (size_t)v * M * 32, 1.f / DM, 8, ssq + (size_t)(13 + 2 * j) * M * 32, ssq + (size_t)(14 + 2 * j) * M * 32}; pg8::gemm_phase(lds, g, S, E, tid); }
          PH_RELOAD
          { const int wv = __builtin_amdgcn_readfirstlane(tid >> 6); const int cG = (G == 256) ? 96 : G, cc = (G == 256) ? bid - 160 : bid;
            if (cc >= 0) convert_descs(q, lds, layer == 0 ? 1 : 4, cc * 8 + wv, cG * 8, wv, tid & 63); } PH_END
        PH_BEGIN(P0 + 1) { const bf16_t* Wuq = (const bf16_t*)(ws + OFF_WMLA + (size_t)j * 20 * MiB + 5 * MiB);
            pg8::Gemm g{(const bf16_t*)(ws + S_C), Wuq, M, NQ, 512, CA, 512}; pg8::StaticOrder S; S.init(M, NQ, G, bid);
            pg8::EpiBf16S<false> E{(bf16_t*)(ws + S_QRAW), NQ, ssq + (size_t)(13 + 2 * j) * M * 32, 1.f / 512, 2, nullptr, nullptr}; pg8::gemm_phase(lds, g, S, E, tid); }
          PH_RELOAD
          { const bf16_t* Wukv = (const bf16_t*)(ws + OFF_WMLA + (size_t)j * 20 * MiB + 8 * MiB);
            pg8::Gemm g{(const bf16_t*)(ws + S_C) + 512, Wukv, M, NKV, 512, CA, 512}; pg8::StaticOrder S; S.init(M, NKV, G, bid);
            pg8::EpiBf16S<false> E{(bf16_t*)(ws + S_KVRAW), NKV, ssq + (size_t)(14 + 2 * j) * M * 32, 1.f / 512, 2, nullptr, nullptr}; pg8::gemm_phase(lds, g, S, E, tid); } PH_END
        PH_BEGIN(P0 + 2) mla_prep(q, lds, G, bid, tid, j); PH_END
        PH_BEGIN(P0 + 3) attn_phase(q, lds, G, bid, tid); PH_END
        PH_BEGIN(P0 + 4) { const bf16_t* Wo = (const bf16_t*)(ws + OFF_WMLA + (size_t)j * 20 * MiB + 12 * MiB);
            pg8::Gemm g{(const bf16_t*)(ws + S_O), Wo, M, DM, DM, DM, DM}; pg8::StaticOrder S; S.init(M, DM, G, bid);
            pg8::EpiRes E{layer == 0 ? q->in[0] : nullptr, hfA, hbB, hfB, ssq + (size_t)(v + 1) * M * 32, nullptr}; pg8::gemm_phase(lds, g, S, E, tid); } PH_END
    } else {
        PH_BEGIN(P0 + 0) { const bf16_t* Win = (const bf16_t*)(ws + OFF_WHG + (size_t)j * 40 * MiB);
            pg8::Gemm g{hfA, Win, M, NHG, DM, DM, DM}; pg8::StaticOrder S; S.init(M, NHG, G, bid);
            pg8::EpiHgrnIn E{(bf16_t*)(ws + S_QS), (bf16_t*)(ws + S_LOGF), (bf16_t*)(ws + S_KK), (bf16_t*)(ws + S_V), (bf16_t*)(ws + S_GS), (const float*)(ws + OFF_LB) + layer * DM, ssq + (size_t)v * M * 32, 1.f / DM};
            pg8::gemm_phase(lds, g, S, E, tid); } PH_END
        PH_BEGIN(P0 + 1) hgrn_phaseA(q, lds, G, bid, tid); PH_END
        PH_BEGIN(P0 + 2) hgrn_phaseB(q, G, bid, tid); PH_END
        PH_BEGIN(P0 + 3) hgrn_phaseC(q, lds, G, bid, tid, j); PH_END
        PH_BEGIN(P0 + 4) { const bf16_t* Wo = (const bf16_t*)(ws + OFF_WHG + (size_t)j * 40 * MiB + 32 * MiB);
            pg8::Gemm g{(const bf16_t*)(ws + S_OG), Wo, M, DM, DM, DM, DM}; pg8::StaticOrder S; S.init(M, DM, G, bid);
            pg8::EpiRes E{nullptr, hfA, hbB, hfB, ssq + (size_t)(v + 1) * M * 32, nullptr}; pg8::gemm_phase(lds, g, S, E, tid); } PH_END
    }
    cur ^= 1;
    PH_BEGIN(P0 + 5) { const bf16_t* Wfi = (const bf16_t*)(ws + OFF_W + (size_t)layer * 75 * MiB);
        pg8::Gemm g{hfA, Wfi, M, 2 * DFF, DM, DM, DM}; pg8::StaticOrder S; S.init(M, 2 * DFF, G, bid);
        pg8::EpiFfnIn E{(bf16_t*)(ws + S_GATE), (bf16_t*)(ws + S_UP), (bf16_t*)(ws + S_ACT), ssq + (size_t)(v + 1) * M * 32, 1.f / DM, q->in[19] + (size_t)layer * 3 * DFF, q->in[20] + (size_t)layer * DFF};
        pg8::gemm_phase(lds, g, S, E, tid); }
      PH_RELOAD
      { const int pG = (G == 256) ? 128 : G, pc = (G == 256) ? bid - 128 : bid;
        if (pc >= 0) { const bf16_t* Wpp = (const bf16_t*)(ws + OFF_W + (size_t)layer * 75 * MiB + 74 * MiB);
            pg8::Gemm g{(const bf16_t*)(ws + OFF_PB) + (size_t)layer * M * 256, Wpp, M, DM, 256, 256, 256}; pg8::StaticOrder S; S.init(M, DM, pG, pc);
            pg8::EpiProj E{(bf16_t*)(ws + OFF_PROJ)}; pg8::gemm_phase(lds, g, S, E, tid);
            if (layer < 3) { PH_RELOAD const int wv = __builtin_amdgcn_readfirstlane(tid >> 6); convert_descs(q, lds, layer == 0 ? 2 : (layer == 1 ? 3 : 5), pc * 8 + wv, pG * 8, wv, tid & 63); } } } PH_END
    PH_BEGIN(P0 + 6) { const bf16_t* Wfd = (const bf16_t*)(ws + OFF_W + (size_t)layer * 75 * MiB + 44 * MiB);
        pg8::Gemm g{(const bf16_t*)(ws + S_ACT), Wfd, M, DM, DFF, DFF, DFF}; pg8::StaticOrder S; S.init(M, DM, G, bid);
        { pg8::Unit fu; for (int i = 0; S.next(i, fu); ++i) ffn_fixup(q, fu.pm, tid, layer); }
        PH_RELOAD
        pg8::EpiRes E{nullptr, hfA, hbB, hfB, ssq + (size_t)(v + 2) * M * 32, nullptr}; pg8::gemm_phase(lds, g, S, E, tid); } PH_END
    cur ^= 1;
    PH_BEGIN(P0 + 7)
      { const bf16_t* Wpg = (const bf16_t*)(ws + OFF_W + (size_t)layer * 75 * MiB + 66 * MiB);
        pg8::Gemm g{hfA, Wpg, M, DM, DM, DM, DM}; pg8::StaticOrder S; S.init(M, DM, G, bid);
        pg8::EpiPle E{hfA, hbB, hfB, ssq + (size_t)(v + 3) * M * 32, (const bf16_t*)(ws + OFF_PROJ), ssq + (size_t)(v + 2) * M * 32, 1.f / DM, layer == 3 ? H : nullptr}; pg8::gemm_phase(lds, g, S, E, tid); } PH_END
}

__global__ void __launch_bounds__(512, 2) trunk_fwd(Params p_unused) {
    extern __shared__ __attribute__((aligned(16))) unsigned char lds_raw[];
    LAS unsigned char* lds = (LAS unsigned char*)lds_raw;
    const int wid_s = __builtin_amdgcn_readfirstlane((int)threadIdx.x >> 6);
    PP pk = (PP)__builtin_amdgcn_kernarg_segment_ptr();
    const int lo = pk->ph_lo, hi = pk->ph_hi;
    { int t0 = threadIdx.x; if (t0 == 0) { volatile LAS unsigned* st = (volatile LAS unsigned*)(lds + LDS_BARST); st[0] = 0u; st[1] = 0u;
        if (hi - lo > 1) (void)xb_add(&((unsigned*)(pk->ws + OFF_BAR))[XB_XCNT(xb_xcc_id())], 1u); } __syncthreads(); }
    if (lo < 0) cg::this_grid().sync();
    { const int cur = 0; PH_BEGIN(0) prologue(q, lds, G, bid, tid); PH_END }
    run_layer<0>(pk, lds, lo, hi, wid_s);
    run_layer<1>(pk, lds, lo, hi, wid_s);
    run_layer<2>(pk, lds, lo, hi, wid_s);
    run_layer<3>(pk, lds, lo, hi, wid_s);
}
#undef PH_BEGIN
#undef PH_END
#undef PH_RELOAD

extern "C" void kernel_launch(void* const* d_in, const int* in_sizes, int n_in, void* d_out, int out_size, void* d_ws, size_t ws_size, hipStream_t stream) {
    static int grid = 0;
    if (grid == 0) {
        if (n_in != 24 || out_size != M * DM || ws_size < WS_NEED) { fprintf(stderr, "kernel_launch: unexpected problem (n_in %d, out %d, ws %zu)\n", n_in, out_size, ws_size); grid = -1; return; }
        int dev = 0, cus = 0, per_cu = 0;
        hipGetDevice(&dev); hipDeviceGetAttribute(&cus, hipDeviceAttributeMultiprocessorCount, dev);
        if (hipFuncSetAttribute((const void*)trunk_fwd, hipFuncAttributeMaxDynamicSharedMemorySize, LDS_BYTES) != hipSuccess) { fprintf(stderr, "kernel_launch: hipFuncSetAttribute failed\n"); grid = -1; return; }
        hipOccupancyMaxActiveBlocksPerMultiprocessor(&per_cu, (const void*)trunk_fwd, 512, LDS_BYTES);
        if (per_cu < 1) per_cu = 1;
        grid = cus * 1;
        (void)hipGetLastError();
    }
    if (grid < 0) return;
    Params p{};
    for (int i = 0; i < 24; ++i) p.in[i] = (const float*)d_in[i];
    p.out = (float*)d_out; p.ws = (unsigned char*)d_ws;
    unsigned char* ws = (unsigned char*)d_ws;
    int nd = 0;
    auto add = [&](const float* W, const float* gain, size_t off, int K, int N, int mode, int slot = 0) { mode |= slot << 4; TrDesc& t = p.tr[nd++]; t.W = W; t.gain = gain; t.WT = (bf16_t*)(ws + off); t.K = K; t.N = N; t.ldk = K; t.mode = mode; };
    const float* mixn = p.in[3]; const float* ffnn = p.in[4]; const float* plen = p.in[5];
    for (int j = 0; j < 2; ++j) {
        const size_t wm = OFF_WMLA + (size_t)j * 20 * MiB; const int layer = 2 * j;
        add(p.in[6] + (size_t)j * DM * 1088, mixn + layer * DM, wm, DM, 1088, 2);
        add(p.in[8] + (size_t)j * 512 * NQ, p.in[7] + j * 512, wm + 5 * MiB, 512, NQ, 0);
        add(p.in[10] + (size_t)j * 512 * NKV, p.in[9] + j * 512, wm + 8 * MiB, 512, NKV, 0);
        add(p.in[13] + (size_t)j * DM * DM, nullptr, wm + 12 * MiB, DM, DM, 0, j == 0 ? 0 : 3);
        const size_t wh = OFF_WHG + (size_t)j * 40 * MiB; const int hl = 2 * j + 1;
        add(p.in[15] + (size_t)j * DM * NHG, mixn + hl * DM, wh, DM, NHG, 2, j == 0 ? 1 : 4);
        add(p.in[17] + (size_t)j * DM * DM, nullptr, wh + 32 * MiB, DM, DM, 0, j == 0 ? 2 : 5);
    }
    for (int l = 0; l < 4; ++l) {
        const size_t wl = OFF_W + (size_t)l * 75 * MiB;
        add(p.in[18] + (size_t)l * DM * 2 * DFF, ffnn + l * DM, wl, DM, 2 * DFF, 3);
        add(p.in[21] + (size_t)l * DFF * DM, nullptr, wl + 44 * MiB, DFF, DM, 0, l == 0 ? 0 : (l == 1 ? 2 : (l == 2 ? 3 : 5)));
        add(p.in[23] + (size_t)l * DM * DM, plen + l * DM, wl + 66 * MiB, DM, DM, 2);
        add(p.in[22] + (size_t)l * 256 * DM, nullptr, wl + 74 * MiB, 256, DM, 0);
    }
#if MK_ONE_LAUNCH
    if (hipMemsetAsync(ws + OFF_BAR, 0, 16384, stream) != hipSuccess) fprintf(stderr, "kernel_launch: memset failed\n");
    p.ph_lo = 0; p.ph_hi = NPHASES;
    void* args[] = {&p};
    hipError_t e = hipLaunchCooperativeKernel((const void*)trunk_fwd, dim3(grid), dim3(512), args, LDS_BYTES, stream);
    if (e != hipSuccess) fprintf(stderr, "cooperative launch failed: %s (grid %d)\n", hipGetErrorString(e), grid);
#else
    for (int ph = 0; ph < NPHASES; ++ph) {
        p.ph_lo = ph; p.ph_hi = ph + 1;
        hipLaunchKernelGGL(trunk_fwd, dim3(grid), dim3(512), LDS_BYTES, stream, p);
    }
#endif
}
```
